# Optimizing an MI355X kernel written in HIP

```python
import jax, jax.numpy as jnp
from jax import lax
import numpy as np

D_MODEL = 4096
BATCH = 1
SEQ = 8192
DEPTH = 1

MIX_WIDTH = D_MODEL
HEAD_DIM = 128
SB_WIDTH = MIX_WIDTH // 2
SB_HEADS = SB_WIDTH // HEAD_DIM
SGU_WIDTH = MIX_WIDTH - SB_WIDTH
SGU_GROUP = 128
SGU_GROUPS = SGU_WIDTH // SGU_GROUP
CHUNK = 128
Q_BLOCK = 128
IN_COLS = 3 * SB_WIDTH + 2 * SGU_WIDTH
PEER_HEADS = 8
PEER_NKEYS = 128
PEER_EXPERTS = PEER_NKEYS * PEER_NKEYS
PEER_QDIM = 512
PEER_HALF = PEER_QDIM // 2
PEER_TOPK = 16
PEER_TOK_CHUNK = 64
EPS = 1e-6

kernel_name = "hymba_style_stickbreak_sgu_peer"


def rms_norm(x, g):
    xf = x.astype(jnp.float32)
    y = xf * lax.rsqrt(jnp.mean(xf * xf, axis=-1, keepdims=True) + EPS)
    return (y * g.astype(jnp.float32)).astype(x.dtype)


def stick_breaking_attention(q, k, v):
    B, H, S, Dh = q.shape
    nb = S // Q_BLOCK
    qb = q.reshape(B, H, nb, Q_BLOCK, Dh).transpose(2, 0, 1, 3, 4)
    starts = jnp.arange(nb, dtype=jnp.int32) * Q_BLOCK
    kpos = jnp.arange(S, dtype=jnp.int32)
    kf = k.astype(jnp.float32)
    vf = v.astype(jnp.float32)
    scale = HEAD_DIM ** -0.5

    def block(args):
        qblk, start = args
        z = jnp.einsum('bhqd,bhkd->bhqk', qblk.astype(jnp.float32), kf) * scale
        qpos = start + jnp.arange(Q_BLOCK, dtype=jnp.int32)
        mask = kpos[None, :] < qpos[:, None]
        log_1m = jnp.where(mask, jax.nn.log_sigmoid(-z), 0.0)
        suffix = lax.cumsum(log_1m, axis=3, reverse=True) - log_1m
        a = jnp.where(mask, jnp.exp(jax.nn.log_sigmoid(z) + suffix), 0.0)
        return jnp.einsum('bhqk,bhkd->bhqd', a, vf)

    out = lax.map(block, (qb, starts))
    return out.transpose(1, 2, 0, 3, 4).reshape(B, H, S, Dh)


def spatial_gating(u, v, v_norm_g, w_s, b_s):
    B, S, _ = u.shape
    nc = S // CHUNK
    v5 = v.reshape(B, nc, CHUNK, SGU_GROUPS, SGU_GROUP)
    vn = rms_norm(v5, v_norm_g.reshape(SGU_GROUPS, SGU_GROUP))
    w_causal = jnp.tril(w_s)
    mixed = jnp.einsum('gts,bnsgc->bntgc', w_causal, vn) + b_s.T[:, :, None]
    out = u.reshape(B, nc, CHUNK, SGU_GROUPS, SGU_GROUP) * mixed
    return out.reshape(B, S, SGU_WIDTH).astype(u.dtype)


def peer_ffn(h, w_q, sub_keys, u_tab, v_tab):
    B, S, D = h.shape
    T = B * S
    K = PEER_TOPK
    t = h.reshape(T, D)
    q = (t @ w_q).reshape(T, PEER_HEADS, 2, PEER_HALF)
    scores = jnp.einsum('thpd,hpnd->thpn', q, sub_keys).astype(jnp.float32)
    s_top, i_top = lax.top_k(scores, K)
    cand = (s_top[:, :, 0, :, None] + s_top[:, :, 1, None, :]).reshape(T, PEER_HEADS, K * K)
    best, flat = lax.top_k(cand, K)
    i1 = jnp.take_along_axis(i_top[:, :, 0], flat // K, axis=-1)
    i2 = jnp.take_along_axis(i_top[:, :, 1], flat % K, axis=-1)
    expert = (i1 * PEER_NKEYS + i2).reshape(T, PEER_HEADS * K)
    gate = jax.nn.softmax(best, axis=-1).reshape(T, PEER_HEADS * K)
    nt = T // PEER_TOK_CHUNK

    def chunk(args):
        tc, ec, gc = args
        uc = u_tab[ec]
        act = jax.nn.gelu(jnp.einsum('cd,ced->ce', tc, uc).astype(jnp.float32))
        coef = (gc * act).astype(tc.dtype)
        return jnp.einsum('ce,ced->cd', coef, v_tab[ec])

    out = lax.map(chunk, (t.reshape(nt, PEER_TOK_CHUNK, D),
                          expert.reshape(nt, PEER_TOK_CHUNK, PEER_HEADS * K),
                          gate.reshape(nt, PEER_TOK_CHUNK, PEER_HEADS * K)))
    return out.reshape(B, S, D).astype(h.dtype)


def setup_inputs(seed: int = 0) -> dict:
    key = jax.random.key(seed)
    ks = jax.random.split(key, 16)
    f32 = jnp.float32
    nrm = lambda k, shape, s: jax.random.normal(k, shape, f32) * s
    gain = lambda k, shape: 1.0 + 0.02 * jax.random.normal(k, shape, f32)
    return {
        "x": nrm(ks[0], (BATCH, SEQ, D_MODEL), 1.0),
        "mix_norm_g": gain(ks[1], (DEPTH, D_MODEL)),
        "w_in": nrm(ks[2], (DEPTH, D_MODEL, IN_COLS), D_MODEL ** -0.5),
        "q_norm_g": gain(ks[3], (DEPTH, HEAD_DIM)),
        "k_norm_g": gain(ks[4], (DEPTH, HEAD_DIM)),
        "sgu_v_norm_g": gain(ks[5], (DEPTH, SGU_WIDTH)),
        "sgu_w": nrm(ks[6], (DEPTH, SGU_GROUPS, CHUNK, CHUNK), CHUNK ** -0.5),
        "sgu_b": 1.0 + 0.1 * jax.random.normal(ks[7], (DEPTH, SGU_GROUPS, CHUNK), f32),
        "sb_out_norm_g": gain(ks[8], (DEPTH, SB_WIDTH)),
        "sgu_out_norm_g": gain(ks[9], (DEPTH, SGU_WIDTH)),
        "w_out": nrm(ks[10], (DEPTH, MIX_WIDTH, D_MODEL), MIX_WIDTH ** -0.5),
        "ffn_norm_g": gain(ks[11], (DEPTH, D_MODEL)),
        "peer_w_q": nrm(ks[12], (DEPTH, D_MODEL, PEER_HEADS * PEER_QDIM), D_MODEL ** -0.5),
        "peer_sub_keys": nrm(ks[13], (DEPTH, PEER_HEADS, 2, PEER_NKEYS, PEER_HALF), PEER_HALF ** -0.5),
        "peer_u": nrm(ks[14], (DEPTH, PEER_EXPERTS, D_MODEL), D_MODEL ** -0.5),
        "peer_v": nrm(ks[15], (DEPTH, PEER_EXPERTS, D_MODEL), PEER_HEADS ** -0.5),
    }


def reference(x, mix_norm_g, w_in, q_norm_g, k_norm_g, sgu_v_norm_g, sgu_w, sgu_b,
              sb_out_norm_g, sgu_out_norm_g, w_out, ffn_norm_g, peer_w_q, peer_sub_keys,
              peer_u, peer_v):
    B, S, _ = x.shape
    h = x
    for l in range(DEPTH):
        hn = rms_norm(h, mix_norm_g[l])
        proj = hn @ w_in[l]
        q, k, v, u_s, v_s = jnp.split(
            proj, [SB_WIDTH, 2 * SB_WIDTH, 3 * SB_WIDTH, 3 * SB_WIDTH + SGU_WIDTH], axis=-1)
        to_heads = lambda a: a.reshape(B, S, SB_HEADS, HEAD_DIM).transpose(0, 2, 1, 3)
        qh = rms_norm(to_heads(q), q_norm_g[l])
        kh = rms_norm(to_heads(k), k_norm_g[l])
        sb = stick_breaking_attention(qh, kh, to_heads(v))
        sb = sb.transpose(0, 2, 1, 3).reshape(B, S, SB_WIDTH).astype(x.dtype)
        sgu = spatial_gating(jax.nn.gelu(u_s), jax.nn.gelu(v_s),
                             sgu_v_norm_g[l], sgu_w[l], sgu_b[l])
        mixed = jnp.concatenate([rms_norm(sb, sb_out_norm_g[l]),
                                 rms_norm(sgu, sgu_out_norm_g[l])], axis=-1)
        h = h + mixed @ w_out[l]
        h = h + peer_ffn(rms_norm(h, ffn_norm_g[l]), peer_w_q[l], peer_sub_keys[l],
                         peer_u[l], peer_v[l])
    return h
```

```cpp
#include <hip/hip_runtime.h>
#include <cstdio>
#include <cstdint>

#ifndef MK_N_LAUNCHES
#define MK_N_LAUNCHES 6
#endif

namespace pg8 {
#define PG8_LAS __attribute__((address_space(3)))
typedef unsigned short bf16_t;
typedef short bf16x8 __attribute__((ext_vector_type(8)));
typedef float f32x4 __attribute__((ext_vector_type(4)));
typedef float f32x2 __attribute__((ext_vector_type(2)));
typedef unsigned u32x4 __attribute__((ext_vector_type(4)));
typedef unsigned u32x2 __attribute__((ext_vector_type(2)));
constexpr int BM = 256, BK = 64, HALF = 128, HTB = HALF * BK * 2, STAGE_BYTES = 8 * HTB, NXCD = 8, WGM = 8;

__host__ __device__ __forceinline__ int lds_byte(int r, int c) { const int st = (r >> 4) * 2 + (c >> 5), rr = r & 15, cc = c & 31, ob = rr * 64 + cc * 2; return st * 1024 + (ob ^ (((ob >> 9) & 1) << 5)); }
__host__ __device__ __forceinline__ void stage_rc(int b, int& R, int& C) { const int st = b / 1024, sb = b % 1024, swz = sb ^ (((sb >> 9) & 1) << 5); R = (st >> 1) * 16 + swz / 64; C = (st & 1) * 32 + (swz % 64) / 2; }
__host__ __device__ __forceinline__ int perm32(int rho) { const int n = rho >> 4, i = rho & 15; return 8 * (i >> 2) + 4 * n + (i & 3); }

struct Unit { int pm, pn; };
struct Gemm { const bf16_t* A; const bf16_t* Bt; int M, N, K; };

struct StaticOrder {
    int nM, nN, nwg, G, c;
    __host__ __device__ void init(int M, int N, int G_, int c_) { nM = M / BM; nN = N / BM; nwg = nM * nN; G = G_; c = c_; }
    __host__ __device__ bool next(int i, Unit& u) const {
        const long L = (long)i * G + c; if (L >= nwg) return false;
        int wgid = (int)L; { const int q = nwg / NXCD, r = nwg % NXCD, xcd = wgid % NXCD, off = wgid / NXCD; wgid = (xcd < r ? xcd * (q + 1) : r * (q + 1) + (xcd - r) * q) + off; }
        const int nig = WGM * nN, gid = wgid / nig, fm = gid * WGM, gsz = (nM - fm) < WGM ? (nM - fm) : WGM;
        u.pm = fm + ((wgid % nig) % gsz); u.pn = (wgid % nig) / gsz; return true;
    }
    __device__ __forceinline__ void a_ready(const Unit&) const {}
    __device__ __forceinline__ void done(const Unit&) const {}
};

__device__ __forceinline__ unsigned cvt_pk_bf16(float lo, float hi) { unsigned r; asm volatile("v_cvt_pk_bf16_f32 %0, %1, %2" : "=v"(r) : "v"(lo), "v"(hi)); return r; }
__device__ __forceinline__ float gelu_tanh(float x) {
    const float t = x * (1.0f + 0.044715f * x * x) * (-2.3022081985f);
    return x * __builtin_amdgcn_rcpf(1.0f + __builtin_amdgcn_exp2f(t));
}

struct EpiQKU {
    static constexpr bool PERM = true, AFTER_DRAIN = false;
    bf16_t* O;
    __device__ __forceinline__ void operator()(const f32x4 (&acc)[2][2][4][2], const Unit& u, int wr, int wc, int fr, int fq) const {
        const int row0 = u.pm * BM + wr * 64 + fr; const int t = u.pn >> 3; const int colt = (u.pn & 7) * BM;
        bf16_t* base = O + (size_t)t * ((size_t)8192 * 2048); const int col0 = colt + wc * 32 + 8 * fq;
#pragma unroll
        for (int ai = 0; ai < 2; ++ai)
#pragma unroll
            for (int m = 0; m < 4; ++m) { bf16_t* rowp = base + (size_t)(row0 + ai * HALF + m * 16) * 2048 + col0;
#pragma unroll
                for (int bj = 0; bj < 2; ++bj) { f32x4 v0 = acc[ai][bj][m][0], v1 = acc[ai][bj][m][1];
                    if (t == 2) {
#pragma unroll
                        for (int j = 0; j < 4; ++j) { v0[j] = gelu_tanh(v0[j]); v1[j] = gelu_tanh(v1[j]); } }
                    u32x4 w; w.x = cvt_pk_bf16(v0[0], v0[1]); w.y = cvt_pk_bf16(v0[2], v0[3]); w.z = cvt_pk_bf16(v1[0], v1[1]); w.w = cvt_pk_bf16(v1[2], v1[3]);
                    *(u32x4*)(rowp + bj * HALF) = w; } }
    }
};
struct EpiVT {
    static constexpr bool PERM = true, AFTER_DRAIN = false;
    bf16_t* O; float* part;
    __device__ __forceinline__ void operator()(const f32x4 (&acc)[2][2][4][2], const Unit& u, int wr, int wc, int fr, int fq) const {
        const int row0 = u.pm * BM + wr * 64 + fr, col0 = u.pn * BM + wc * 32 + 8 * fq; const bool sg = u.pm >= 8;
#pragma unroll
        for (int ai = 0; ai < 2; ++ai) {
            f32x4 cs[2][2];
#pragma unroll
            for (int bj = 0; bj < 2; ++bj) { cs[bj][0] = (f32x4){0.f, 0.f, 0.f, 0.f}; cs[bj][1] = (f32x4){0.f, 0.f, 0.f, 0.f}; }
#pragma unroll
            for (int m = 0; m < 4; ++m) { bf16_t* rowp = O + (size_t)(row0 + ai * HALF + m * 16) * 8192 + col0;
#pragma unroll
                for (int bj = 0; bj < 2; ++bj) { f32x4 v0 = acc[ai][bj][m][0], v1 = acc[ai][bj][m][1];
                    if (sg) {
#pragma unroll
                        for (int j = 0; j < 4; ++j) { v0[j] = gelu_tanh(v0[j]); v1[j] = gelu_tanh(v1[j]); }
                        cs[bj][0] += v0 * v0; cs[bj][1] += v1 * v1; }
                    u32x4 w; w.x = cvt_pk_bf16(v0[0], v0[1]); w.y = cvt_pk_bf16(v0[2], v0[3]); w.z = cvt_pk_bf16(v1[0], v1[1]); w.w = cvt_pk_bf16(v1[2], v1[3]);
                    *(u32x4*)(rowp + bj * HALF) = w; } }
            if (sg) {
                const int g = (u.pm - 8) * 2 + ai;
#pragma unroll
                for (int bj = 0; bj < 2; ++bj)
#pragma unroll
                    for (int n = 0; n < 2; ++n) { f32x4 s = cs[bj][n];
#pragma unroll
                        for (int off = 1; off < 16; off <<= 1) { s[0] += __shfl_xor(s[0], off); s[1] += __shfl_xor(s[1], off); s[2] += __shfl_xor(s[2], off); s[3] += __shfl_xor(s[3], off); }
                        if (fr == 0) *(f32x4*)(part + ((size_t)wr * 16 + g) * 8192 + col0 + bj * HALF + 4 * n) = s; }
            }
        }
    }
};
struct EpiH {
    static constexpr bool PERM = true, AFTER_DRAIN = false;
    const float* x; float* out; bf16_t* hb; float* hss;
    __device__ __forceinline__ void operator()(const f32x4 (&acc)[2][2][4][2], const Unit& u, int wr, int wc, int fr, int fq) const {
        const int row0 = u.pm * BM + wr * 64 + fr, col0 = u.pn * BM + wc * 32 + 8 * fq;
#pragma unroll
        for (int ai = 0; ai < 2; ++ai)
#pragma unroll
            for (int m = 0; m < 4; ++m) { const int row = row0 + ai * HALF + m * 16; const size_t off = (size_t)row * 4096 + col0; float ss = 0.f;
#pragma unroll
                for (int bj = 0; bj < 2; ++bj) { const f32x4 x0 = *(const f32x4*)(x + off + bj * HALF), x1 = *(const f32x4*)(x + off + bj * HALF + 4);
                    const f32x4 h0 = x0 + acc[ai][bj][m][0], h1 = x1 + acc[ai][bj][m][1];
                    *(f32x4*)(out + off + bj * HALF) = h0; *(f32x4*)(out + off + bj * HALF + 4) = h1;
                    ss += (h0[0] * h0[0] + h0[1] * h0[1]) + (h0[2] * h0[2] + h0[3] * h0[3]) + (h1[0] * h1[0] + h1[1] * h1[1]) + (h1[2] * h1[2] + h1[3] * h1[3]);
                    u32x4 w; w.x = cvt_pk_bf16(h0[0], h0[1]); w.y = cvt_pk_bf16(h0[2], h0[3]); w.z = cvt_pk_bf16(h1[0], h1[1]); w.w = cvt_pk_bf16(h1[2], h1[3]);
                    *(u32x4*)(hb + off + bj * HALF) = w; }
                ss += __shfl_xor(ss, 16); ss += __shfl_xor(ss, 32);
                if (fq == 0) hss[(size_t)(u.pn * 4 + wc) * 8192 + row] = ss;
                asm volatile("" ::: "memory"); }
    }
};
struct EpiF32 {
    static constexpr bool PERM = false, AFTER_DRAIN = false;
    float* C; int ldc;
    __device__ __forceinline__ void operator()(const f32x4 (&acc)[2][2][4][2], const Unit& u, int wr, int wc, int fr, int fq) const {
        const int row0 = u.pm * BM + wr * 64 + fr, col0 = u.pn * BM + wc * 32 + 4 * fq;
#pragma unroll
        for (int ai = 0; ai < 2; ++ai)
#pragma unroll
            for (int m = 0; m < 4; ++m) { float* rowp = C + (size_t)(row0 + ai * HALF + m * 16) * ldc + col0;
#pragma unroll
                for (int bj = 0; bj < 2; ++bj)
#pragma unroll
                    for (int n = 0; n < 2; ++n) *(f32x4*)(rowp + bj * HALF + n * 16) = acc[ai][bj][m][n]; }
    }
};

template <class Epi, class Sched, bool ALIGN_EPI = false, bool SP2 = false>
__device__ __forceinline__ void gemm_phase(PG8_LAS unsigned char* lds, const Gemm g, const Sched& S, const Epi& E) {
    const int tid = threadIdx.x, wid = __builtin_amdgcn_readfirstlane(tid >> 6), lane = tid & 63, wr = wid >> 2, wc = wid & 3, fr = lane & 15, fq = lane >> 4;
    const int K = g.K, nt = K / BK;
    unsigned voffA[2], voffB[2];
#pragma unroll
    for (int i = 0; i < 2; ++i) { int R, C; stage_rc(tid * 16 + i * 8192, R, C); const int Rb = Epi::PERM ? ((R & ~31) + perm32(R & 31)) : R;
        voffA[i] = (unsigned)(R * K + C) * 2u; voffB[i] = (unsigned)(Rb * K + C) * 2u; }
    const size_t kstep = (size_t)(BK * 2);
    const size_t hstep = (size_t)HALF * K * 2;
    const size_t tstep = 2 * hstep;
    const unsigned ldsw = (unsigned)wid * 1024u;
    const int aoff = lds_byte(wr * 64 + fr, fq * 8), boff = lds_byte(wc * 32 + fr, fq * 8);
#define PG8_SA(b, h) (((b) * 2 + (h)) * HTB)
#define PG8_SB(b, h) ((4 + (b) * 2 + (h)) * HTB)
#define PG8_STAGE(bufoff, gbase, voff) do { _Pragma("unroll") for (int _i = 0; _i < 2; ++_i) \
        __builtin_amdgcn_global_load_lds((const unsigned*)((const char*)(gbase) + (voff)[_i]), (PG8_LAS unsigned*)(lds + (bufoff) + ldsw + _i * 8192), 16, 0, 0); } while (0)
#define PG8_LDA(dst, b, h) do { _Pragma("unroll") for (int m = 0; m < 4; ++m) _Pragma("unroll") for (int k = 0; k < 2; ++k) dst[m][k] = *(const PG8_LAS bf16x8*)(lds + PG8_SA(b, h) + aoff + m * 2048 + k * 1024); } while (0)
#define PG8_LDB(dst, b, h) do { _Pragma("unroll") for (int n = 0; n < 2; ++n) _Pragma("unroll") for (int k = 0; k < 2; ++k) dst[n][k] = *(const PG8_LAS bf16x8*)(lds + PG8_SB(b, h) + boff + n * 2048 + k * 1024); } while (0)
#define PG8_MMA(ai, bj, At, Bt) do { __builtin_amdgcn_s_setprio(1); _Pragma("unroll") for (int m = 0; m < 4; ++m) _Pragma("unroll") for (int n = 0; n < 2; ++n) _Pragma("unroll") for (int k = 0; k < 2; ++k) \
        acc[ai][bj][m][n] = __builtin_amdgcn_mfma_f32_16x16x32_bf16(Bt[n][k], At[m][k], acc[ai][bj][m][n], 0, 0, 0); __builtin_amdgcn_s_setprio(0); } while (0)
#define PG8_WAIT_V(n) asm volatile("s_waitcnt vmcnt(" #n ")" ::: "memory")
#define PG8_WAIT_L(n) asm volatile("s_waitcnt lgkmcnt(" #n ")" ::: "memory")
#define PG8_BAR __builtin_amdgcn_s_barrier()
#define PG8_SCHED __builtin_amdgcn_sched_barrier(0)
    Unit cur, nxt; int ui = 0;
    if (!S.next(0, cur)) return;
    f32x4 acc[2][2][4][2];
#pragma unroll
    for (int a = 0; a < 2; ++a)
#pragma unroll
        for (int b = 0; b < 2; ++b)
#pragma unroll
            for (int m = 0; m < 4; ++m)
#pragma unroll
                for (int n = 0; n < 2; ++n) acc[a][b][m][n] = (f32x4){0.f, 0.f, 0.f, 0.f};
    bf16x8 At[4][2], B0[2][2], B1[2][2];
    const char* cA = (const char*)g.A + (size_t)cur.pm * tstep; const char* cB = (const char*)g.Bt + (size_t)cur.pn * tstep;
    S.a_ready(cur);
    if constexpr (SP2) {
        PG8_STAGE(PG8_SB(0, 0), cB, voffB); PG8_STAGE(PG8_SB(0, 1), cB + hstep, voffB); PG8_STAGE(PG8_SA(0, 0), cA, voffA); PG8_STAGE(PG8_SA(0, 1), cA + hstep, voffA);
        if (wr == 1) PG8_BAR;
        PG8_WAIT_V(2); PG8_BAR;
        PG8_STAGE(PG8_SB(1, 0), cB + kstep, voffB); PG8_STAGE(PG8_SA(1, 0), cA + kstep, voffA); PG8_STAGE(PG8_SB(1, 1), cB + hstep + kstep, voffB);
        PG8_WAIT_V(6); PG8_BAR;
    } else {
        PG8_STAGE(PG8_SB(0, 0), cB, voffB); PG8_STAGE(PG8_SA(0, 0), cA, voffA); PG8_STAGE(PG8_SB(0, 1), cB + hstep, voffB); PG8_STAGE(PG8_SA(0, 1), cA + hstep, voffA);
        if (wr == 1) PG8_BAR;
        PG8_WAIT_V(4); PG8_BAR;
        PG8_STAGE(PG8_SB(1, 0), cB + kstep, voffB); PG8_STAGE(PG8_SA(1, 0), cA + kstep, voffA); PG8_STAGE(PG8_SB(1, 1), cB + hstep + kstep, voffB);
        PG8_WAIT_V(6); PG8_BAR;
    }
    for (;;) {
        const bool has_next = S.next(ui + 1, nxt);
        const char* nA = has_next ? (const char*)g.A + (size_t)nxt.pm * tstep : cA; const char* nB = has_next ? (const char*)g.Bt + (size_t)nxt.pn * tstep : cB;
        for (int t = 0; t < nt; t += 2) {
            const bool last = (t == nt - 2);
            const char* a1 = cA + (size_t)(t + 1) * kstep;
            const char* a2 = last ? nA : cA + (size_t)(t + 2) * kstep; const char* b2 = last ? nB : cB + (size_t)(t + 2) * kstep;
            const char* a3 = a2 + kstep; const char* b3 = b2 + kstep;
            if (last && has_next) S.a_ready(nxt);
            if constexpr (SP2) {
            PG8_LDB(B0, 0, 0); PG8_LDB(B1, 0, 1); PG8_SCHED; PG8_LDA(At, 0, 0); PG8_STAGE(PG8_SA(1, 1), a1 + hstep, voffA);
            PG8_WAIT_V(8); PG8_WAIT_L(0); PG8_BAR; PG8_MMA(0, 0, At, B0); PG8_MMA(0, 1, At, B1); PG8_BAR; PG8_SCHED;
            PG8_LDA(At, 0, 1); PG8_STAGE(PG8_SB(0, 0), b2, voffB); PG8_STAGE(PG8_SB(0, 1), b2 + hstep, voffB); PG8_STAGE(PG8_SA(0, 0), a2, voffA);
            PG8_WAIT_V(8); PG8_WAIT_L(0); PG8_BAR; PG8_MMA(1, 0, At, B0); PG8_MMA(1, 1, At, B1); PG8_BAR; PG8_SCHED;
            PG8_LDB(B0, 1, 0); PG8_LDB(B1, 1, 1); PG8_SCHED; PG8_LDA(At, 1, 0); PG8_STAGE(PG8_SA(0, 1), a2 + hstep, voffA);
            PG8_WAIT_V(8); PG8_WAIT_L(0); PG8_BAR; PG8_MMA(0, 0, At, B0); PG8_MMA(0, 1, At, B1); PG8_BAR; PG8_SCHED;
            PG8_LDA(At, 1, 1); PG8_STAGE(PG8_SB(1, 0), b3, voffB); PG8_STAGE(PG8_SB(1, 1), b3 + hstep, voffB); PG8_STAGE(PG8_SA(1, 0), a3, voffA);
            PG8_WAIT_V(8); PG8_WAIT_L(0); PG8_BAR; PG8_MMA(1, 0, At, B0); PG8_MMA(1, 1, At, B1); PG8_BAR; PG8_SCHED;
            } else {
            PG8_LDB(B0, 0, 0); PG8_SCHED; PG8_LDA(At, 0, 0); PG8_STAGE(PG8_SA(1, 1), a1 + hstep, voffA);
            PG8_WAIT_L(8); PG8_BAR; PG8_WAIT_L(0); PG8_MMA(0, 0, At, B0); PG8_BAR; PG8_SCHED;
            PG8_LDB(B1, 0, 1); PG8_STAGE(PG8_SB(0, 0), b2, voffB);
            PG8_BAR; PG8_WAIT_L(0); PG8_MMA(0, 1, At, B1); PG8_BAR;
            PG8_LDA(At, 0, 1); PG8_STAGE(PG8_SA(0, 0), a2, voffA);
            PG8_BAR; PG8_WAIT_L(0); PG8_MMA(1, 0, At, B0); PG8_BAR; PG8_SCHED;
            PG8_STAGE(PG8_SB(0, 1), b2 + hstep, voffB);
            PG8_WAIT_V(6); PG8_BAR; PG8_MMA(1, 1, At, B1); PG8_BAR;
            PG8_LDB(B0, 1, 0); PG8_SCHED; PG8_LDA(At, 1, 0); PG8_STAGE(PG8_SA(0, 1), a2 + hstep, voffA);
            PG8_WAIT_L(8); PG8_BAR; PG8_WAIT_L(0); PG8_MMA(0, 0, At, B0); PG8_BAR; PG8_SCHED;
            PG8_LDB(B1, 1, 1); PG8_STAGE(PG8_SB(1, 0), b3, voffB);
            PG8_BAR; PG8_WAIT_L(0); PG8_MMA(0, 1, At, B1); PG8_BAR;
            PG8_LDA(At, 1, 1); PG8_STAGE(PG8_SA(1, 0), a3, voffA);
            PG8_BAR; PG8_WAIT_L(0); PG8_MMA(1, 0, At, B0); PG8_BAR; PG8_SCHED;
            PG8_STAGE(PG8_SB(1, 1), b3 + hstep, voffB);
            PG8_WAIT_V(6); PG8_BAR; PG8_MMA(1, 1, At, B1); PG8_BAR;
            }
        }
        if constexpr (ALIGN_EPI) { if (wr == 0) PG8_BAR; }
        if constexpr (!Epi::AFTER_DRAIN) { E(acc, cur, wr, wc, fr, fq); S.done(cur); }
        if (!has_next) break;
#pragma unroll
        for (int a = 0; a < 2; ++a)
#pragma unroll
            for (int b = 0; b < 2; ++b)
#pragma unroll
                for (int m = 0; m < 4; ++m)
#pragma unroll
                    for (int n = 0; n < 2; ++n) acc[a][b][m][n] = (f32x4){0.f, 0.f, 0.f, 0.f};
        cur = nxt; cA = nA; cB = nB; ++ui;
        if constexpr (ALIGN_EPI) { if (wr == 1) PG8_BAR; }
    }
    PG8_WAIT_V(0);
    if constexpr (!ALIGN_EPI) { if (wr == 0) PG8_BAR; }
    PG8_BAR;
#undef PG8_SA
#undef PG8_SB
#undef PG8_STAGE
#undef PG8_LDA
#undef PG8_LDB
#undef PG8_MMA
#undef PG8_WAIT_V
#undef PG8_WAIT_L
#undef PG8_BAR
#undef PG8_SCHED
}
}

constexpr int NWAVES = 8;
constexpr int N_LAUNCHES = MK_N_LAUNCHES;
constexpr int PER_PHASE = 6;
constexpr int T = 8192, DM = 4096, SBW = 2048, NHEAD = 16, HD = 128, NGRP = 16;
constexpr int NA = 6144, MB = 4096;
constexpr int PH = 8, PNK = 128, PHALF = 256, PK = 16, NEXP = 16384, NSC = 2048;
constexpr float EPS = 1e-6f;
constexpr float ATT_EXIT = 160.0f;
constexpr float QSCALE = 0.08838834764831845f * 1.4426950408889634f;

constexpr size_t MiB = 1u << 20;
constexpr size_t WS_CTL = 0, CTL_ZERO_BYTES = 1 * MiB;
constexpr size_t WS_XN = 1 * MiB;
constexpr size_t WS_WA = 65 * MiB;
constexpr size_t WS_WB = 113 * MiB;
constexpr size_t WS_WO = 145 * MiB;
constexpr size_t WS_WS = 177 * MiB;
constexpr size_t WS_QKU = 193 * MiB;
constexpr size_t WS_VG = 289 * MiB;
constexpr size_t WS_GVP = 353 * MiB;
constexpr size_t WS_MIX = 354 * MiB;
constexpr size_t WS_HB = 418 * MiB;
constexpr size_t WS_HSS = 482 * MiB;
constexpr size_t WS_SC = 484 * MiB;
constexpr size_t WS_UT = 548 * MiB;
constexpr size_t WS_VT = 676 * MiB;
constexpr size_t WS_END = 804 * MiB;
constexpr int CW_TMO = 0, CW_CODE = 1;
constexpr int CW_BAR = 4096;

constexpr int RING_OFF = 0, RING_BYTES = 131072;
constexpr int LDSCTL_OFF = RING_BYTES, MISC_OFF = LDSCTL_OFF + 320;
constexpr int LDS_BYTES = 147456;

#define GAS __attribute__((address_space(1)))
#define LAS __attribute__((address_space(3)))
#define DI __device__ __forceinline__
typedef unsigned short bf16;
typedef unsigned v4u __attribute__((ext_vector_type(4)));
typedef unsigned v2u __attribute__((ext_vector_type(2)));
typedef float f32x4 __attribute__((ext_vector_type(4)));
typedef float f32x2 __attribute__((ext_vector_type(2)));
typedef float f32x16 __attribute__((ext_vector_type(16)));
typedef short bf16x8 __attribute__((ext_vector_type(8)));
typedef __bf16 bf16x2_t __attribute__((ext_vector_type(2)));
typedef GAS unsigned gu32;
#define RLX_AGENT __ATOMIC_RELAXED, __HIP_MEMORY_SCOPE_AGENT
#define LDS_WAIT() asm volatile("s_waitcnt lgkmcnt(0)" ::: "memory")
#define VM_WAIT() asm volatile("s_waitcnt vmcnt(0)" ::: "memory")
#define MFMA32(a, b, c) __builtin_amdgcn_mfma_f32_32x32x16_bf16((a), (b), (c), 0, 0, 0)

DI unsigned f2bf(float f) { unsigned u = __builtin_bit_cast(unsigned, f); return (u + 0x7fffu + ((u >> 16) & 1u)) >> 16; }
DI unsigned pk2(float lo, float hi) { f32x2 v = {lo, hi}; bf16x2_t b = __builtin_convertvector(v, bf16x2_t); return __builtin_bit_cast(unsigned, b); }
DI float bflo(unsigned u) { return __uint_as_float(u << 16); }
DI float bfhi(unsigned u) { return __uint_as_float(u & 0xffff0000u); }
DI int crow(int i, int h) { return (i & 3) + 8 * (i >> 2) + 4 * h; }
DI float swap_add(float x) { auto rr = __builtin_amdgcn_permlane32_swap(__float_as_uint(x), __float_as_uint(x), false, false); return __uint_as_float(rr[0]) + __uint_as_float(rr[1]); }
DI float dot2bf(unsigned a, unsigned b, float c) { return __builtin_amdgcn_fdot2_f32_bf16(__builtin_bit_cast(bf16x2_t, a), __builtin_bit_cast(bf16x2_t, b), c, false); }
DI bf16x8 pack8(float a0, float a1, float a2, float a3, float a4, float a5, float a6, float a7) { v4u p; p.x = pk2(a0, a1); p.y = pk2(a2, a3); p.z = pk2(a4, a5); p.w = pk2(a6, a7); return __builtin_bit_cast(bf16x8, p); }
DI float wave_sum(float v) {
#pragma unroll
    for (int o = 1; o < 64; o <<= 1) v += __shfl_xor(v, o);
    return v;
}

#define XB_TMO      128
#define XB_XCNT(j)  (256  + 64 * (j))
#define XB_XSUB(j)  (1280 + 64 * (j))
#define XB_XGEN(j)  (2304 + 64 * (j))
#define XB_TOP      3328
#define XB_TOPGEN   3392
#define XCD_BAR_WORDS 3456
#define XB_SPIN_CAP (1u << 18)
DI unsigned xb_ld(unsigned* p)              { return __hip_atomic_load(p, __ATOMIC_RELAXED, __HIP_MEMORY_SCOPE_AGENT); }
DI unsigned xb_add(unsigned* p, unsigned v) { return __hip_atomic_fetch_add(p, v, __ATOMIC_RELAXED, __HIP_MEMORY_SCOPE_AGENT); }
DI unsigned xb_xcc_id() { return (unsigned)__builtin_amdgcn_s_getreg((3 << 11) | 20) & 0xFu; }
#define XB_SPIN(cond, bar) do { unsigned _sp = 0; while (cond) { __builtin_amdgcn_s_sleep(1); \
    if ((++_sp & 255u) == 0u) { if (xb_ld(&(bar)[XB_TMO])) break; if (_sp > XB_SPIN_CAP) { atomicAdd(&(bar)[XB_TMO], 1u); break; } } } } while (0)
struct XcdBarrier { unsigned* bar; unsigned x; volatile LAS unsigned* st; };
DI XcdBarrier xcd_barrier_post(unsigned* bar, volatile LAS unsigned* st) {
    XcdBarrier b; b.bar = bar; b.x = xb_xcc_id(); b.st = st;
    if (threadIdx.x == 0) (void)xb_add(&bar[XB_XCNT(b.x)], 1u);
    return b;
}
DI void xcd_barrier_complete(unsigned* bar, unsigned x, unsigned& nloc, unsigned& nx) {
    const unsigned G = gridDim.x * gridDim.y * gridDim.z;
    unsigned sum, cnt, mine, sp = 0u;
    for (;;) {
        sum = 0u; cnt = 0u; mine = 0u;
#pragma unroll
        for (unsigned j = 0; j < 16; ++j) { const unsigned c = xb_ld(&bar[XB_XCNT(j)]); sum += c; cnt += (c > 0u) ? 1u : 0u; mine = (j == x) ? c : mine; }
        if (sum == G) break;
        __builtin_amdgcn_s_sleep(1);
        if ((++sp & 255u) == 0u) { if (xb_ld(&bar[XB_TMO])) break; if (sp > XB_SPIN_CAP) { atomicAdd(&bar[XB_TMO], 1u); break; } }
    }
    nloc = mine > 0u ? mine : 1u; nx = cnt > 0u ? cnt : 1u;
}
DI void xcd_barrier(const XcdBarrier& b) {
    asm volatile("s_waitcnt vmcnt(0)" ::: "memory");
    __syncthreads();
    if (threadIdx.x == 0) {
        unsigned* bar = b.bar;
        __builtin_amdgcn_s_waitcnt(0);
        unsigned nloc = b.st[0], nx = b.st[1];
        if (nloc == 0u) { xcd_barrier_complete(bar, b.x, nloc, nx); b.st[0] = nloc; b.st[1] = nx; }
        const unsigned old = xb_add(&bar[XB_XSUB(b.x)], 1u);
        const unsigned gen = old / nloc;
        if (old + 1u == (gen + 1u) * nloc) {
            __builtin_amdgcn_fence(__ATOMIC_RELEASE, "agent");
            asm volatile("s_waitcnt vmcnt(0)" ::: "memory");
            const unsigned og = xb_add(&bar[XB_TOP], 1u);
            const unsigned tg = og / nx;
            if (og + 1u == (tg + 1u) * nx) xb_add(&bar[XB_TOPGEN], 1u);
            else XB_SPIN(xb_ld(&bar[XB_TOPGEN]) == tg, bar);
            __builtin_amdgcn_fence(__ATOMIC_ACQUIRE, "agent");
            xb_add(&bar[XB_XGEN(b.x)], 1u);
            asm volatile("s_waitcnt vmcnt(0)" ::: "memory");
        } else {
            XB_SPIN(xb_ld(&bar[XB_XGEN(b.x)]) == gen, bar);
            __builtin_amdgcn_fence(__ATOMIC_ACQUIRE, "agent");
            asm volatile("s_waitcnt vmcnt(0)" ::: "memory");
        }
    }
    __syncthreads();
}

struct Frame {
    LAS unsigned char* lds;
    volatile LAS unsigned* MISC;
    gu32* ctl;
    int tid, lane, wave;
    int vcu, G;
    const float *x, *mix_g, *w_in, *q_g, *k_g, *sgu_vg, *sgu_w, *sgu_b, *sb_og, *sgu_og, *w_out, *ffn_g, *w_q, *keys, *pu, *pv;
    float* out;
    bf16 *XN, *WA, *WB, *WO, *WS, *QKU, *VG, *MIX, *HB, *UT, *VT;
    float *GVP, *HSS, *SC;
};

DI void p0_transpose_item(const float* W, int N, int k0, int n0, bf16* dst_row0, int K, LAS float* scr, int lane) {
#pragma unroll 8
    for (int i = 0; i < 32; ++i) { const int kk = 2 * i + (lane >> 5); scr[kk * 33 + (lane & 31)] = W[(size_t)(k0 + kk) * N + n0 + (lane & 31)]; }
    LDS_WAIT(); asm volatile("" ::: "memory");
    const int c = lane & 7;
#pragma unroll
    for (int j = 0; j < 4; ++j) { const int n = (lane >> 3) + 8 * j; const LAS float* s = scr + (8 * c) * 33 + n;
        v4u o; o.x = pk2(s[0 * 33], s[1 * 33]); o.y = pk2(s[2 * 33], s[3 * 33]); o.z = pk2(s[4 * 33], s[5 * 33]); o.w = pk2(s[6 * 33], s[7 * 33]);
        *(GAS v4u*)(dst_row0 + (size_t)n * K + k0 + 8 * c) = o; }
    LDS_WAIT(); asm volatile("" ::: "memory");
}
DI void rms_row_to_bf16(const float* xrow, const float* g, bf16* orow, int lane) {
    const GAS f32x4* xr = (const GAS f32x4*)xrow + lane; const GAS f32x4* gr = (const GAS f32x4*)g + lane;
    f32x4 v[16]; float s = 0.f;
#pragma unroll
    for (int j = 0; j < 16; ++j) { v[j] = xr[64 * j]; s += (v[j].x * v[j].x + v[j].y * v[j].y) + (v[j].z * v[j].z + v[j].w * v[j].w); }
    const float rstd = __builtin_amdgcn_rsqf(wave_sum(s) * (1.f / DM) + EPS);
    GAS v2u* o8 = (GAS v2u*)orow + lane;
#pragma unroll
    for (int j = 0; j < 16; ++j) { const f32x4 gg = gr[64 * j]; v2u o; o.x = pk2(v[j].x * rstd * gg.x, v[j].y * rstd * gg.y); o.y = pk2(v[j].z * rstd * gg.z, v[j].w * rstd * gg.w); o8[64 * j] = o; }
}
DI void p0_ws_item(Frame& F, int item) {
    const int hp = item >> 7, dblk = item & 127, lane = F.lane, r = lane & 31, h = lane >> 5;
    const float* ap = F.w_q + (size_t)(dblk * 32 + r) * DM + hp * 256 + 8 * h;
    const float* bp = F.keys + ((size_t)hp * 128 + r) * 256 + 8 * h;
    f32x16 d[4];
#pragma unroll
    for (int nb = 0; nb < 4; ++nb)
#pragma unroll
        for (int i = 0; i < 16; ++i) d[nb][i] = 0.f;
#pragma unroll 4
    for (int s = 0; s < 16; ++s) {
        const f32x4 a0 = *(const f32x4*)(ap + 16 * s), a1 = *(const f32x4*)(ap + 16 * s + 4);
        const bf16x8 af = pack8(a0.x, a0.y, a0.z, a0.w, a1.x, a1.y, a1.z, a1.w);
#pragma unroll
        for (int nb = 0; nb < 4; ++nb) {
            const f32x4 b0 = *(const f32x4*)(bp + (size_t)nb * 32 * 256 + 16 * s), b1 = *(const f32x4*)(bp + (size_t)nb * 32 * 256 + 16 * s + 4);
            const bf16x8 bfr = pack8(b0.x, b0.y, b0.z, b0.w, b1.x, b1.y, b1.z, b1.w);
            d[nb] = MFMA32(af, bfr, d[nb]);
        }
    }
#pragma unroll
    for (int m = 0; m < 4; ++m) { const int dd = dblk * 32 + 8 * m + 4 * h; const f32x4 g = *(const f32x4*)(F.ffn_g + dd);
#pragma unroll
        for (int nb = 0; nb < 4; ++nb) { v2u o; o.x = pk2(d[nb][4 * m] * g.x, d[nb][4 * m + 1] * g.y); o.y = pk2(d[nb][4 * m + 2] * g.z, d[nb][4 * m + 3] * g.w);
            *(GAS v2u*)(F.WS + (size_t)(hp * 128 + nb * 32 + r) * DM + dd) = o; } }
}
DI void p0_prologue(Frame& F) {
    LAS float* scr = (LAS float*)(F.lds + RING_OFF + F.wave * 16384);
    const int gw = F.vcu * NWAVES + F.wave, NGW = F.G * NWAVES;
    for (int m = gw; m < T; m += NGW) rms_row_to_bf16(F.x + (size_t)m * DM, F.mix_g, F.XN + (size_t)m * DM, F.lane);
    constexpr int NIN = 10240, I_IN = (DM / 64) * (NIN / 32), I_O = (DM / 64) * (DM / 32);
    for (int it = gw; it < I_IN + I_O; it += NGW) {
        if (it < I_IN) { const int nblk = NIN / 32, kb = it / nblk, nb = it % nblk, n0 = 32 * nb, seg = n0 >> 11, within = n0 & 2047;
            bf16* dst = (seg == 0 || seg == 1) ? F.WA + (size_t)n0 * DM : (seg == 2) ? F.WB + (size_t)within * DM : (seg == 3) ? F.WA + (size_t)(4096 + within) * DM : F.WB + (size_t)(2048 + within) * DM;
            p0_transpose_item(F.w_in, NIN, 64 * kb, n0, dst, DM, scr, F.lane);
        } else { const int r = it - I_IN, nblk = DM / 32, kb = r / nblk, nb = r % nblk;
            p0_transpose_item(F.w_out, DM, 64 * kb, 32 * nb, F.WO + (size_t)(32 * nb) * DM, DM, scr, F.lane); }
    }
    for (int it = gw; it < 16 * 128; it += NGW) p0_ws_item(F, it);
    { const size_t nchunk = (size_t)NEXP * DM / 8; const size_t gt = (size_t)F.vcu * (NWAVES * 64) + F.tid, NT = (size_t)F.G * NWAVES * 64;
      for (size_t c = gt; c < nchunk; c += NT) { const size_t e0 = c * 8; const int d0 = (int)(e0 & (DM - 1));
          const f32x4 g0 = *(const f32x4*)(F.ffn_g + d0), g1 = *(const f32x4*)(F.ffn_g + d0 + 4);
          const f32x4 a0 = *(const GAS f32x4*)(F.pu + e0), a1 = *(const GAS f32x4*)(F.pu + e0 + 4);
          const f32x4 b0 = *(const GAS f32x4*)(F.pv + e0), b1 = *(const GAS f32x4*)(F.pv + e0 + 4);
          v4u ou, ov; ou.x = pk2(a0.x * g0.x, a0.y * g0.y); ou.y = pk2(a0.z * g0.z, a0.w * g0.w); ou.z = pk2(a1.x * g1.x, a1.y * g1.y); ou.w = pk2(a1.z * g1.z, a1.w * g1.w);
          ov.x = pk2(b0.x, b0.y); ov.y = pk2(b0.z, b0.w); ov.z = pk2(b1.x, b1.y); ov.w = pk2(b1.z, b1.w);
          *(GAS v4u*)(F.UT + e0) = ou; *(GAS v4u*)(F.VT + e0) = ov; } }
}

DI void attn_head(Frame& F, int hd, int q0, LAS float* scr, float& ssq) {
    const int lane = F.lane, r = lane & 31, h = lane >> 5;
    const bf16* qraw = F.QKU; const bf16* kraw = F.QKU + (size_t)T * SBW; const bf16* vT = F.VG;
    bf16x8 qf[8];
    { const bf16* qp = qraw + (size_t)(q0 + r) * SBW + hd * HD + 8 * h;
      v4u raw[8]; float ss = 0.f;
#pragma unroll
      for (int s = 0; s < 8; ++s) raw[s] = *(const GAS v4u*)(qp + 16 * s);
#pragma unroll
      for (int s = 0; s < 8; ++s)
#pragma unroll
          for (int w = 0; w < 4; ++w) ss = dot2bf(raw[s][w], raw[s][w], ss);
      ss = swap_add(ss);
      const float rq = __builtin_amdgcn_rsqf(ss * (1.f / HD) + EPS) * QSCALE;
#pragma unroll
      for (int s = 0; s < 8; ++s) { const int d0 = 16 * s + 8 * h;
          const f32x4 a0 = *(const f32x4*)(F.q_g + d0), a1 = *(const f32x4*)(F.q_g + d0 + 4), b0 = *(const f32x4*)(F.k_g + d0), b1 = *(const f32x4*)(F.k_g + d0 + 4);
          qf[s] = pack8(bflo(raw[s][0]) * rq * a0.x * b0.x, bfhi(raw[s][0]) * rq * a0.y * b0.y, bflo(raw[s][1]) * rq * a0.z * b0.z, bfhi(raw[s][1]) * rq * a0.w * b0.w,
                        bflo(raw[s][2]) * rq * a1.x * b1.x, bfhi(raw[s][2]) * rq * a1.y * b1.y, bflo(raw[s][3]) * rq * a1.z * b1.z, bfhi(raw[s][3]) * rq * a1.w * b1.w); }
    }
    f32x16 o[4];
#pragma unroll
    for (int db = 0; db < 4; ++db)
#pragma unroll
        for (int i = 0; i < 16; ++i) o[db][i] = 0.f;
    float cdec = 0.f;
    for (int kt = q0; kt >= 0; kt -= 32) {
        const bool diag = (kt == q0);
        const bf16* kp = kraw + (size_t)(kt + r) * SBW + hd * HD + 8 * h;
        v4u kr[8];
#pragma unroll
        for (int s = 0; s < 8; ++s) kr[s] = *(const GAS v4u*)(kp + 16 * s);
        float ks = 0.f;
#pragma unroll
        for (int s = 0; s < 8; ++s)
#pragma unroll
            for (int w = 0; w < 4; ++w) ks = dot2bf(kr[s][w], kr[s][w], ks);
        ks = swap_add(ks);
        const float rkl = __builtin_amdgcn_rsqf(ks * (1.f / HD) + EPS);
        f32x16 st;
#pragma unroll
        for (int i = 0; i < 16; ++i) st[i] = 0.f;
#pragma unroll
        for (int s = 0; s < 8; ++s) st = MFMA32(__builtin_bit_cast(bf16x8, kr[s]), qf[s], st);
        asm volatile("" ::: "memory");
        const bf16* vp = vT + (size_t)(hd * HD + r) * T + kt + 4 * h;
        v2u vlo[4][2], vhi[4][2];
#pragma unroll
        for (int db = 0; db < 4; ++db)
#pragma unroll
            for (int s2 = 0; s2 < 2; ++s2) { vlo[db][s2] = *(const GAS v2u*)(vp + (size_t)db * 32 * T + 16 * s2); vhi[db][s2] = *(const GAS v2u*)(vp + (size_t)db * 32 * T + 16 * s2 + 8); }
        if (h == 0) scr[r] = rkl;
        f32x4 rk4[4];
#pragma unroll
        for (int m = 0; m < 4; ++m) rk4[m] = *(const LAS f32x4*)(scr + 8 * m + 4 * h);
        float z[16], sp[16];
#pragma unroll
        for (int i = 0; i < 16; ++i) { z[i] = st[i] * rk4[i >> 2][i & 3]; const float e = __builtin_amdgcn_exp2f(-__builtin_fabsf(z[i])); sp[i] = __builtin_fmaxf(z[i], 0.f) + __builtin_amdgcn_logf(1.0f + e); }
        if (diag) {
#pragma unroll
            for (int i = 0; i < 16; ++i) if (!(crow(i, h) < r)) sp[i] = 0.f; }
        float G[8];
#pragma unroll
        for (int m = 0; m < 4; ++m) { const float sm = (sp[4 * m] + sp[4 * m + 1]) + (sp[4 * m + 2] + sp[4 * m + 3]);
            auto rr = __builtin_amdgcn_permlane32_swap(__float_as_uint(sm), __float_as_uint(sm), false, false); G[2 * m] = __uint_as_float(rr[0]); G[2 * m + 1] = __uint_as_float(rr[1]); }
        float Tg[8]; Tg[7] = 0.f;
#pragma unroll
        for (int g = 6; g >= 0; --g) Tg[g] = Tg[g + 1] + G[g + 1];
        const float total = Tg[0] + G[0];
        float a[16];
#pragma unroll
        for (int m = 0; m < 4; ++m) { const float s3 = cdec + (h ? Tg[2 * m + 1] : Tg[2 * m]); const float s2 = s3 + sp[4 * m + 3], s1 = s2 + sp[4 * m + 2], s0 = s1 + sp[4 * m + 1];
            a[4 * m + 3] = __builtin_amdgcn_exp2f(z[4 * m + 3] - sp[4 * m + 3] - s3); a[4 * m + 2] = __builtin_amdgcn_exp2f(z[4 * m + 2] - sp[4 * m + 2] - s2);
            a[4 * m + 1] = __builtin_amdgcn_exp2f(z[4 * m + 1] - sp[4 * m + 1] - s1); a[4 * m] = __builtin_amdgcn_exp2f(z[4 * m] - sp[4 * m] - s0); }
        if (diag) {
#pragma unroll
            for (int i = 0; i < 16; ++i) if (!(crow(i, h) < r)) a[i] = 0.f; }
        cdec += total;
        const bf16x8 af0 = pack8(a[0], a[1], a[2], a[3], a[4], a[5], a[6], a[7]), af1 = pack8(a[8], a[9], a[10], a[11], a[12], a[13], a[14], a[15]);
#pragma unroll
        for (int db = 0; db < 4; ++db) {
            v4u v0; v0.x = vlo[db][0].x; v0.y = vlo[db][0].y; v0.z = vhi[db][0].x; v0.w = vhi[db][0].y;
            v4u v1; v1.x = vlo[db][1].x; v1.y = vlo[db][1].y; v1.z = vhi[db][1].x; v1.w = vhi[db][1].y;
            o[db] = MFMA32(__builtin_bit_cast(bf16x8, v0), af0, o[db]); o[db] = MFMA32(__builtin_bit_cast(bf16x8, v1), af1, o[db]); }
        if (__all(cdec > ATT_EXIT)) break;
    }
    float ss = 0.f;
#pragma unroll
    for (int db = 0; db < 4; ++db)
#pragma unroll
        for (int i = 0; i < 16; ++i) ss += o[db][i] * o[db][i];
    ssq += swap_add(ss);
    bf16* orow = F.MIX + (size_t)(q0 + r) * DM + hd * HD + 4 * h;
#pragma unroll
    for (int db = 0; db < 4; ++db)
#pragma unroll
        for (int m = 0; m < 4; ++m) { v2u p; p.x = pk2(o[db][4 * m], o[db][4 * m + 1]); p.y = pk2(o[db][4 * m + 2], o[db][4 * m + 3]); *(GAS v2u*)(orow + db * 32 + 8 * m) = p; }
}
DI void sgu_group(Frame& F, int g, int n, int rq, LAS float* scr, float& ssq) {
    const int lane = F.lane, r = lane & 31, h = lane >> 5;
    const bf16* gvT = F.VG + (size_t)SBW * T;
    const bf16* ub = F.QKU + (size_t)2 * T * SBW;
#pragma unroll
    for (int i = 0; i < 2; ++i) { const int s = lane + 64 * i; const float p = F.GVP[(size_t)g * T + 128 * n + s] + F.GVP[(size_t)(16 + g) * T + 128 * n + s];
        scr[s] = __builtin_amdgcn_rsqf(p * (1.f / 128.f) + EPS); }
    f32x16 d[4];
#pragma unroll
    for (int cb = 0; cb < 4; ++cb)
#pragma unroll
        for (int i = 0; i < 16; ++i) d[cb][i] = 0.f;
    const int tl = 32 * rq + r;
    const float* wrow = F.sgu_w + ((size_t)g * 128 + tl) * 128 + 8 * h;
    const bf16* ap = gvT + (size_t)(g * 128 + r) * T + 128 * n + 8 * h;
    const int nks = 2 * (rq + 1);
    for (int ks = 0; ks < nks; ++ks) {
        const f32x4 w0 = *(const f32x4*)(wrow + 16 * ks), w1 = *(const f32x4*)(wrow + 16 * ks + 4);
        const f32x4 r0 = *(const LAS f32x4*)(scr + 16 * ks + 8 * h), r1 = *(const LAS f32x4*)(scr + 16 * ks + 8 * h + 4);
        const int s0 = 16 * ks + 8 * h;
        float wv[8] = {w0.x * r0.x, w0.y * r0.y, w0.z * r0.z, w0.w * r0.w, w1.x * r1.x, w1.y * r1.y, w1.z * r1.z, w1.w * r1.w};
#pragma unroll
        for (int j = 0; j < 8; ++j) if (s0 + j > tl) wv[j] = 0.f;
        const bf16x8 bfr = pack8(wv[0], wv[1], wv[2], wv[3], wv[4], wv[5], wv[6], wv[7]);
#pragma unroll
        for (int cb = 0; cb < 4; ++cb) { const v4u av = *(const GAS v4u*)(ap + (size_t)cb * 32 * T + 16 * ks); d[cb] = MFMA32(__builtin_bit_cast(bf16x8, av), bfr, d[cb]); }
    }
    const float bias = F.sgu_b[g * 128 + tl];
    const size_t trow = (size_t)(128 * n + tl);
    float ss = 0.f;
#pragma unroll
    for (int cb = 0; cb < 4; ++cb)
#pragma unroll
        for (int m = 0; m < 4; ++m) { const int c0 = cb * 32 + 8 * m + 4 * h; const f32x4 gg = *(const f32x4*)(F.sgu_vg + g * 128 + c0);
            const v2u uu = *(const GAS v2u*)(ub + trow * SBW + g * 128 + c0);
            const float o0 = bflo(uu.x) * (d[cb][4 * m] * gg.x + bias), o1 = bfhi(uu.x) * (d[cb][4 * m + 1] * gg.y + bias), o2 = bflo(uu.y) * (d[cb][4 * m + 2] * gg.z + bias), o3 = bfhi(uu.y) * (d[cb][4 * m + 3] * gg.w + bias);
            ss += (o0 * o0 + o1 * o1) + (o2 * o2 + o3 * o3);
            v2u p; p.x = pk2(o0, o1); p.y = pk2(o2, o3); *(GAS v2u*)(F.MIX + trow * DM + SBW + g * 128 + c0) = p; }
    ssq += swap_add(ss);
}
DI void renorm(bf16* rowp, const float* gain, float rstd) {
#pragma unroll
    for (int db = 0; db < 4; ++db)
#pragma unroll
        for (int m = 0; m < 4; ++m) { const int c0 = db * 32 + 8 * m; const f32x4 gg = *(const f32x4*)(gain + c0); const v2u q = *(const GAS v2u*)(rowp + c0);
            v2u p; p.x = pk2(bflo(q.x) * rstd * gg.x, bfhi(q.x) * rstd * gg.y); p.y = pk2(bflo(q.y) * rstd * gg.z, bfhi(q.y) * rstd * gg.w);
            *(GAS v2u*)(rowp + c0) = p; }
}
DI void p2_mixers(Frame& F) {
    LAS float* scr = (LAS float*)(F.lds + RING_OFF) + F.wave * 128;
    LAS float* xch = (LAS float*)(F.lds + RING_OFF + 8192);
    const int lane = F.lane, r = lane & 31, h = lane >> 5, w = F.wave;
    for (int unit = F.vcu; unit < T / 32; unit += F.G) {
        const int q0 = 32 * unit, n = unit >> 2, rq = unit & 3;
        float ssa = 0.f, sss = 0.f;
#pragma unroll 1
        for (int hh = 0; hh < 2; ++hh) attn_head(F, 2 * w + hh, q0, scr, ssa);
#pragma unroll 1
        for (int hh = 0; hh < 2; ++hh) sgu_group(F, 2 * w + hh, n, rq, scr, sss);
        if (h == 0) { xch[w * 32 + r] = ssa; xch[256 + w * 32 + r] = sss; }
        VM_WAIT();
        __syncthreads();
        float ta = 0.f, ts = 0.f;
#pragma unroll
        for (int ww = 0; ww < 8; ++ww) { ta += xch[ww * 32 + r]; ts += xch[256 + ww * 32 + r]; }
        const float rsa = __builtin_amdgcn_rsqf(ta * (1.f / SBW) + EPS), rss = __builtin_amdgcn_rsqf(ts * (1.f / SBW) + EPS);
        bf16* drow = F.MIX + (size_t)(q0 + r) * DM + 4 * h;
        renorm(drow + (2 * w) * HD, F.sb_og + (2 * w) * HD + 4 * h, rsa);
        renorm(drow + (2 * w + 1) * HD, F.sb_og + (2 * w + 1) * HD + 4 * h, rsa);
        renorm(drow + SBW + (2 * w) * 128, F.sgu_og + (2 * w) * 128 + 4 * h, rss);
        renorm(drow + SBW + (2 * w + 1) * 128, F.sgu_og + (2 * w + 1) * 128 + 4 * h, rss);
        __syncthreads();
    }
}

template <int CTRL> DI unsigned dpp_u(unsigned v) { return (unsigned)__builtin_amdgcn_update_dpp(0, (int)v, CTRL, 0xF, 0xF, false); }
template <int CTRL> DI float dpp_f(float v) { return __uint_as_float(dpp_u<CTRL>(__float_as_uint(v))); }
DI unsigned umax(unsigned a, unsigned b) { return a > b ? a : b; }
DI unsigned row_umax(unsigned v) { v = umax(v, dpp_u<0xB1>(v)); v = umax(v, dpp_u<0x4E>(v)); v = umax(v, dpp_u<0x124>(v)); v = umax(v, dpp_u<0x128>(v)); return v; }
DI float row_fsum(float v) { v += dpp_f<0xB1>(v); v += dpp_f<0x4E>(v); v += dpp_f<0x124>(v); v += dpp_f<0x128>(v); return v; }
DI unsigned f_ord(float f) { const unsigned u = __float_as_uint(f); return (u & 0x80000000u) ? ~u : (u | 0x80000000u); }
DI float ord_f(unsigned k) { return __uint_as_float((k & 0x80000000u) ? (k ^ 0x80000000u) : ~k); }
DI unsigned bperm(unsigned v, int src_lane) { return (unsigned)__builtin_amdgcn_ds_bpermute(src_lane << 2, (int)v); }

DI void p5_peer(Frame& F) {
    const int lane = F.lane, gw = F.vcu * NWAVES + F.wave, NGW = F.G * NWAVES;
    int pa, pb;
    { const int l = lane;
      if (l < 16) { pa = 0; pb = l; } else if (l < 24) { pa = 1; pb = l - 16; } else if (l < 29) { pa = 2; pb = l - 24; } else if (l < 33) { pa = 3; pb = l - 29; }
      else if (l < 36) { pa = 4; pb = l - 33; } else if (l < 38) { pa = 5; pb = l - 36; } else if (l < 40) { pa = 6; pb = l - 38; } else if (l < 42) { pa = 7; pb = l - 40; }
      else if (l < 50) { pa = l - 34; pb = 0; } else { pa = 0; pb = 0; } }
    const unsigned pab = (unsigned)(pa << 4 | pb);
    for (int t = gw; t < T; t += NGW) {
        const float rstd = __builtin_amdgcn_rsqf(wave_sum(F.HSS[(size_t)lane * T + t]) * (1.f / DM) + EPS);
        v4u hf[8];
        { const GAS v4u* hp = (const GAS v4u*)(F.HB + (size_t)t * DM) + lane;
#pragma unroll
          for (int j = 0; j < 8; ++j) hf[j] = hp[64 * j]; }
        float oacc[64];
#pragma unroll
        for (int i = 0; i < 64; ++i) oacc[i] = 0.f;
        const float* scrow = F.SC + (size_t)t * NSC;
        for (int hd = 0; hd < PH; ++hd) {
            const f32x4 sv = *(const GAS f32x4*)(scrow + hd * 256 + 4 * lane);
            const unsigned idx0 = (unsigned)(4 * (lane & 31));
            unsigned k0 = (f_ord(sv.x) & ~0x7Fu) | idx0, k1 = (f_ord(sv.y) & ~0x7Fu) | (idx0 + 1), k2 = (f_ord(sv.z) & ~0x7Fu) | (idx0 + 2), k3 = (f_ord(sv.w) & ~0x7Fu) | (idx0 + 3);
            unsigned res = 0u;
#pragma unroll
            for (int rnd = 0; rnd < PK; ++rnd) {
                unsigned m = row_umax(umax(umax(k0, k1), umax(k2, k3)));
                const unsigned a0 = (unsigned)__builtin_amdgcn_readlane((int)m, 0), a1 = (unsigned)__builtin_amdgcn_readlane((int)m, 16), b0 = (unsigned)__builtin_amdgcn_readlane((int)m, 32), b1 = (unsigned)__builtin_amdgcn_readlane((int)m, 48);
                const unsigned mh0 = umax(a0, a1), mh1 = umax(b0, b1);
                const unsigned mm = (lane < 32) ? mh0 : mh1;
                k0 = (k0 == mm) ? 0u : k0; k1 = (k1 == mm) ? 0u : k1; k2 = (k2 == mm) ? 0u : k2; k3 = (k3 == mm) ? 0u : k3;
                res = ((lane & 31) == rnd) ? mm : res;
            }
            const unsigned ka = bperm(res, pa), kb = bperm(res, 32 + pb);
            const float cv = ord_f(ka & ~0x7Fu) + ord_f(kb & ~0x7Fu);
            unsigned ck = (lane < 50) ? ((f_ord(cv) & ~0x3Fu) | (unsigned)lane) : 0u;
            unsigned res2 = 0u;
#pragma unroll
            for (int rnd = 0; rnd < PK; ++rnd) {
                const unsigned m = row_umax(ck);
                const unsigned a0 = (unsigned)__builtin_amdgcn_readlane((int)m, 0), a1 = (unsigned)__builtin_amdgcn_readlane((int)m, 16), b0 = (unsigned)__builtin_amdgcn_readlane((int)m, 32), b1 = (unsigned)__builtin_amdgcn_readlane((int)m, 48);
                const unsigned mm = umax(umax(a0, a1), umax(b0, b1));
                ck = (ck == mm) ? 0u : ck;
                res2 = (lane == rnd) ? mm : res2;
            }
            const unsigned pid = res2 & 0x3Fu; const unsigned ab = bperm(pab, (int)pid);
            const unsigned i1 = bperm(res, (int)(ab >> 4)) & 0x7Fu, i2 = bperm(res, 32 + (int)(ab & 15u)) & 0x7Fu;
            const int expert = (int)(i1 * PNK + i2);
            const float best = ord_f(res2 & ~0x3Fu) * rstd;
            const float bmax = __uint_as_float((unsigned)__builtin_amdgcn_readlane((int)__float_as_uint(best), 0));
            const float ex = (lane < 16) ? __builtin_amdgcn_exp2f((best - bmax) * 1.4426950408889634f) : 0.f;
            const float gate = (lane < 16) ? ex * __builtin_amdgcn_rcpf(row_fsum(ex)) : 0.f;
            float part[PK];
#pragma unroll
            for (int k = 0; k < PK; ++k) { const int e = __builtin_amdgcn_readlane(expert, k);
                const GAS v4u* up = (const GAS v4u*)(F.UT + (size_t)e * DM) + lane; float s = 0.f;
#pragma unroll
                for (int j = 0; j < 8; ++j) { const v4u uv = up[64 * j]; s = dot2bf(hf[j].x, uv.x, s); s = dot2bf(hf[j].y, uv.y, s); s = dot2bf(hf[j].z, uv.z, s); s = dot2bf(hf[j].w, uv.w, s); }
                part[k] = s; }
            float act = 0.f;
#pragma unroll
            for (int k = 0; k < PK; ++k) { const float s = wave_sum(part[k]); act = (lane == k) ? s : act; }
            act *= rstd;
            const float coef = gate * pg8::gelu_tanh(act);
#pragma unroll 2
            for (int k = 0; k < PK; ++k) { const int e = __builtin_amdgcn_readlane(expert, k); const float ck2 = __uint_as_float((unsigned)__builtin_amdgcn_readlane((int)__float_as_uint(coef), k));
                const GAS v4u* vp = (const GAS v4u*)(F.VT + (size_t)e * DM) + lane;
#pragma unroll
                for (int j = 0; j < 8; ++j) { const v4u vv = vp[64 * j];
                    oacc[8 * j + 0] += ck2 * bflo(vv.x); oacc[8 * j + 1] += ck2 * bfhi(vv.x); oacc[8 * j + 2] += ck2 * bflo(vv.y); oacc[8 * j + 3] += ck2 * bfhi(vv.y);
                    oacc[8 * j + 4] += ck2 * bflo(vv.z); oacc[8 * j + 5] += ck2 * bfhi(vv.z); oacc[8 * j + 6] += ck2 * bflo(vv.w); oacc[8 * j + 7] += ck2 * bfhi(vv.w); } }
        }
        { GAS f32x4* op = (GAS f32x4*)(F.out + (size_t)t * DM) + 2 * lane;
#pragma unroll
          for (int j = 0; j < 8; ++j) { f32x4 a = op[128 * j], b = op[128 * j + 1];
              a.x += oacc[8 * j]; a.y += oacc[8 * j + 1]; a.z += oacc[8 * j + 2]; a.w += oacc[8 * j + 3]; b.x += oacc[8 * j + 4]; b.y += oacc[8 * j + 5]; b.z += oacc[8 * j + 6]; b.w += oacc[8 * j + 7];
              op[128 * j] = a; op[128 * j + 1] = b; } }
    }
}

struct Args { const float* in[16]; float* out; unsigned char* ws; int ph_lo, ph_hi, li, pad; };
__global__ void __launch_bounds__(NWAVES * 64, 2) mk_fwd(Args args) {
    extern __shared__ __attribute__((aligned(16))) unsigned char lds[];
    Frame F;
    F.lds = (LAS unsigned char*)lds;
    F.MISC = (volatile LAS unsigned*)(F.lds + MISC_OFF);
    F.tid = threadIdx.x; F.lane = F.tid & 63; F.wave = __builtin_amdgcn_readfirstlane(F.tid >> 6);
    F.G = gridDim.x; { const int bx = blockIdx.x; F.vcu = (F.G % 8 == 0) ? (bx % 8) * (F.G / 8) + bx / 8 : bx; }
    unsigned char* ws = args.ws;
    F.ctl = (gu32*)(ws + WS_CTL);
    F.x = args.in[0]; F.mix_g = args.in[1]; F.w_in = args.in[2]; F.q_g = args.in[3]; F.k_g = args.in[4]; F.sgu_vg = args.in[5]; F.sgu_w = args.in[6]; F.sgu_b = args.in[7];
    F.sb_og = args.in[8]; F.sgu_og = args.in[9]; F.w_out = args.in[10]; F.ffn_g = args.in[11]; F.w_q = args.in[12]; F.keys = args.in[13]; F.pu = args.in[14]; F.pv = args.in[15];
    F.out = args.out;
    F.XN = (bf16*)(ws + WS_XN); F.WA = (bf16*)(ws + WS_WA); F.WB = (bf16*)(ws + WS_WB); F.WO = (bf16*)(ws + WS_WO); F.WS = (bf16*)(ws + WS_WS);
    F.QKU = (bf16*)(ws + WS_QKU); F.VG = (bf16*)(ws + WS_VG); F.MIX = (bf16*)(ws + WS_MIX); F.HB = (bf16*)(ws + WS_HB); F.UT = (bf16*)(ws + WS_UT); F.VT = (bf16*)(ws + WS_VT);
    F.GVP = (float*)(ws + WS_GVP); F.HSS = (float*)(ws + WS_HSS); F.SC = (float*)(ws + WS_SC);
    for (int u = F.tid; u < (LDS_BYTES - LDSCTL_OFF) / 4; u += NWAVES * 64) ((LAS unsigned*)(F.lds + LDSCTL_OFF))[u] = 0u;
    __syncthreads();
    XcdBarrier bar; bar.bar = (unsigned*)(F.ctl + CW_BAR); bar.x = 0; bar.st = nullptr;
    if (N_LAUNCHES != PER_PHASE) bar = xcd_barrier_post((unsigned*)(F.ctl + CW_BAR), F.MISC + 8);
#define GRID_BAR() do { if (N_LAUNCHES != PER_PHASE) xcd_barrier(bar); } while (0)
    const int lo = args.ph_lo, hi = args.ph_hi;
#define IN(k) (lo <= (k) && (k) < hi)
#define BOTH(k) (IN(k) && IN((k) + 1))

    if (IN(0)) { p0_prologue(F); if (BOTH(0)) GRID_BAR(); }

    if (IN(1)) {
        { pg8::Gemm g{F.XN, F.WA, T, NA, DM}; pg8::StaticOrder S; S.init(T, NA, F.G, (int)blockIdx.x);
          pg8::EpiQKU E{F.QKU};
          pg8::gemm_phase<pg8::EpiQKU, pg8::StaticOrder, true, true>(F.lds + RING_OFF, g, S, E); }
        { pg8::Gemm g{F.WB, F.XN, MB, T, DM}; pg8::StaticOrder S; S.init(MB, T, F.G, (int)blockIdx.x);
          pg8::EpiVT E{F.VG, F.GVP};
          pg8::gemm_phase<pg8::EpiVT, pg8::StaticOrder, true, true>(F.lds + RING_OFF, g, S, E); }
        if (BOTH(1)) GRID_BAR();
    }

    if (IN(2)) { p2_mixers(F); if (BOTH(2)) GRID_BAR(); }

    if (IN(3)) {
        pg8::Gemm g{F.MIX, F.WO, T, DM, DM}; pg8::StaticOrder S; S.init(T, DM, F.G, (int)blockIdx.x);
        pg8::EpiH E{F.x, F.out, F.HB, F.HSS};
        pg8::gemm_phase<pg8::EpiH, pg8::StaticOrder, true, true>(F.lds + RING_OFF, g, S, E);
        if (BOTH(3)) GRID_BAR();
    }

    if (IN(4)) {
        pg8::Gemm g{F.HB, F.WS, T, NSC, DM}; pg8::StaticOrder S; S.init(T, NSC, F.G, (int)blockIdx.x);
        pg8::EpiF32 E{F.SC, NSC};
        pg8::gemm_phase<pg8::EpiF32, pg8::StaticOrder, false, true>(F.lds + RING_OFF, g, S, E);
        if (BOTH(4)) GRID_BAR();
    }

    if (IN(5)) { p5_peer(F); }
#undef IN
#undef BOTH
}

extern "C" void kernel_launch(void* const* d_in, const int* in_sizes, int n_in, void* d_out, int out_size, void* d_ws, size_t ws_size, hipStream_t stream) {
    static int grid = 0;
    if (grid == 0) {
        if (n_in != 16 || in_sizes[0] != T * DM || out_size != T * DM || ws_size < WS_END) { fprintf(stderr, "kernel_launch: unexpected shapes (n_in %d, in0 %d, out %d, ws %zu); nothing launched\n", n_in, n_in > 0 ? in_sizes[0] : -1, out_size, ws_size); grid = -1; return; }
        int dev = 0, cus = 0, per_cu = 0;
        if (hipGetDevice(&dev) != hipSuccess || hipDeviceGetAttribute(&cus, hipDeviceAttributeMultiprocessorCount, dev) != hipSuccess) { grid = -1; return; }
        if (hipFuncSetAttribute((const void*)mk_fwd, hipFuncAttributeMaxDynamicSharedMemorySize, LDS_BYTES) != hipSuccess) { fprintf(stderr, "kernel_launch: hipFuncSetAttribute failed\n"); grid = -1; return; }
        if (hipOccupancyMaxActiveBlocksPerMultiprocessor(&per_cu, (const void*)mk_fwd, NWAVES * 64, LDS_BYTES) != hipSuccess || per_cu < 1) fprintf(stderr, "kernel_launch: occupancy query reports %d per CU\n", per_cu);
        (void)hipGetLastError();
        grid = cus;
    }
    if (grid < 0) return;
    if (hipMemsetAsync((char*)d_ws + WS_CTL, 0, CTL_ZERO_BYTES, stream) != hipSuccess) return;
    Args a{};
    for (int i = 0; i < 16; ++i) a.in[i] = (const float*)d_in[i];
    a.out = (float*)d_out; a.ws = (unsigned char*)d_ws;
    if (N_LAUNCHES == 1) {
        a.ph_lo = 0; a.ph_hi = PER_PHASE; a.li = 0;
        void* kargs[] = {&a};
        hipError_t e = hipLaunchCooperativeKernel((const void*)mk_fwd, dim3(grid), dim3(NWAVES * 64), kargs, LDS_BYTES, stream);
        if (e != hipSuccess) fprintf(stderr, "kernel_launch: cooperative launch failed: %s (grid %d)\n", hipGetErrorString(e), grid);
    } else {
        for (int li = 0; li < PER_PHASE; ++li) {
            a.ph_lo = li; a.ph_hi = li + 1; a.li = li;
            hipLaunchKernelGGL(mk_fwd, dim3(grid), dim3(NWAVES * 64), LDS_BYTES, stream, a);
        }
    }
}
```

```cpp
#include <hip/hip_runtime.h>
#include <cstdio>
#include <cstdint>

#ifndef MK_N_LAUNCHES
#define MK_N_LAUNCHES 1
#endif

namespace pg8 {
#define PG8_LAS __attribute__((address_space(3)))
typedef unsigned short bf16_t;
typedef short bf16x8 __attribute__((ext_vector_type(8)));
typedef float f32x4 __attribute__((ext_vector_type(4)));
typedef float f32x2 __attribute__((ext_vector_type(2)));
typedef unsigned u32x4 __attribute__((ext_vector_type(4)));
typedef unsigned u32x2 __attribute__((ext_vector_type(2)));
typedef int i32x4 __attribute__((ext_vector_type(4)));
template <bool I8> struct AccT { typedef f32x4 type; };
template <> struct AccT<true> { typedef i32x4 type; };
constexpr int BM = 256, BK = 64, HALF = 128, HTB = HALF * BK * 2, STAGE_BYTES = 8 * HTB, NXCD = 8, WGM = 8;

__host__ __device__ __forceinline__ int lds_byte(int r, int c) { const int st = (r >> 4) * 2 + (c >> 5), rr = r & 15, cc = c & 31, ob = rr * 64 + cc * 2; return st * 1024 + (ob ^ (((ob >> 9) & 1) << 5)); }
__host__ __device__ __forceinline__ void stage_rc(int b, int& R, int& C) { const int st = b / 1024, sb = b % 1024, swz = sb ^ (((sb >> 9) & 1) << 5); R = (st >> 1) * 16 + swz / 64; C = (st & 1) * 32 + (swz % 64) / 2; }
__host__ __device__ __forceinline__ int perm32(int rho) { const int n = rho >> 4, i = rho & 15; return 8 * (i >> 2) + 4 * n + (i & 3); }

struct Unit { int pm, pn; };
struct Gemm { const bf16_t* A; const bf16_t* Bt; int M, N, K; };

struct StaticOrder {
    int nM, nN, nwg, G, c;
    __host__ __device__ void init(int M, int N, int G_, int c_) { nM = M / BM; nN = N / BM; nwg = nM * nN; G = G_; c = c_; }
    __host__ __device__ bool next(int i, Unit& u) const {
        const long L = (long)i * G + c; if (L >= nwg) return false;
        int wgid = (int)L; { const int q = nwg / NXCD, r = nwg % NXCD, xcd = wgid % NXCD, off = wgid / NXCD; wgid = (xcd < r ? xcd * (q + 1) : r * (q + 1) + (xcd - r) * q) + off; }
        const int nig = WGM * nN, gid = wgid / nig, fm = gid * WGM, gsz = (nM - fm) < WGM ? (nM - fm) : WGM;
        u.pm = fm + ((wgid % nig) % gsz); u.pn = (wgid % nig) / gsz; return true;
    }
    __device__ __forceinline__ void a_ready(const Unit&) const {}
    __device__ __forceinline__ void done(const Unit&) const {}
};

__device__ __forceinline__ unsigned cvt_pk_bf16(float lo, float hi) { unsigned r; asm volatile("v_cvt_pk_bf16_f32 %0, %1, %2" : "=v"(r) : "v"(lo), "v"(hi)); return r; }
__device__ __forceinline__ float gelu_tanh(float x) {
    const float t = x * (1.0f + 0.044715f * x * x) * (-2.3022081985f);
    return x * __builtin_amdgcn_rcpf(1.0f + __builtin_amdgcn_exp2f(t));
}

struct EpiQKU {
    static constexpr bool PERM = true, AFTER_DRAIN = false;
    bf16_t* O;
    __device__ __forceinline__ void operator()(const f32x4 (&acc)[2][2][4][2], const Unit& u, int wr, int wc, int fr, int fq) const {
        const int row0 = u.pm * BM + wr * 64 + fr; const int t = u.pn >> 3; const int colt = (u.pn & 7) * BM;
        bf16_t* base = O + (size_t)t * ((size_t)8192 * 2048); const int col0 = colt + wc * 32 + 8 * fq;
#pragma unroll
        for (int ai = 0; ai < 2; ++ai)
#pragma unroll
            for (int m = 0; m < 4; ++m) { bf16_t* rowp = base + (size_t)(row0 + ai * HALF + m * 16) * 2048 + col0;
#pragma unroll
                for (int bj = 0; bj < 2; ++bj) { f32x4 v0 = acc[ai][bj][m][0], v1 = acc[ai][bj][m][1];
                    if (t == 2) {
#pragma unroll
                        for (int j = 0; j < 4; ++j) { v0[j] = gelu_tanh(v0[j]); v1[j] = gelu_tanh(v1[j]); } }
                    u32x4 w; w.x = cvt_pk_bf16(v0[0], v0[1]); w.y = cvt_pk_bf16(v0[2], v0[3]); w.z = cvt_pk_bf16(v1[0], v1[1]); w.w = cvt_pk_bf16(v1[2], v1[3]);
                    *(u32x4*)(rowp + bj * HALF) = w; } }
    }
};
struct EpiVT {
    static constexpr bool PERM = true, AFTER_DRAIN = false;
    bf16_t* O; float* part;
    __device__ __forceinline__ void operator()(const f32x4 (&acc)[2][2][4][2], const Unit& u, int wr, int wc, int fr, int fq) const {
        const int row0 = u.pm * BM + wr * 64 + fr, col0 = u.pn * BM + wc * 32 + 8 * fq; const bool sg = u.pm >= 8;
#pragma unroll
        for (int ai = 0; ai < 2; ++ai) {
            f32x4 cs[2][2];
#pragma unroll
            for (int bj = 0; bj < 2; ++bj) { cs[bj][0] = (f32x4){0.f, 0.f, 0.f, 0.f}; cs[bj][1] = (f32x4){0.f, 0.f, 0.f, 0.f}; }
#pragma unroll
            for (int m = 0; m < 4; ++m) { bf16_t* rowp = O + (size_t)(row0 + ai * HALF + m * 16) * 8192 + col0;
#pragma unroll
                for (int bj = 0; bj < 2; ++bj) { f32x4 v0 = acc[ai][bj][m][0], v1 = acc[ai][bj][m][1];
                    if (sg) {
#pragma unroll
                        for (int j = 0; j < 4; ++j) { v0[j] = gelu_tanh(v0[j]); v1[j] = gelu_tanh(v1[j]); }
                        cs[bj][0] += v0 * v0; cs[bj][1] += v1 * v1; }
                    u32x4 w; w.x = cvt_pk_bf16(v0[0], v0[1]); w.y = cvt_pk_bf16(v0[2], v0[3]); w.z = cvt_pk_bf16(v1[0], v1[1]); w.w = cvt_pk_bf16(v1[2], v1[3]);
                    *(u32x4*)(rowp + bj * HALF) = w; } }
            if (sg) {
                const int g = (u.pm - 8) * 2 + ai;
#pragma unroll
                for (int bj = 0; bj < 2; ++bj)
#pragma unroll
                    for (int n = 0; n < 2; ++n) { f32x4 s = cs[bj][n];
#pragma unroll
                        for (int j = 0; j < 4; ++j) { float v = s[j];
                            v += __uint_as_float((unsigned)__builtin_amdgcn_update_dpp(0, (int)__float_as_uint(v), 0xB1, 0xF, 0xF, false)); v += __uint_as_float((unsigned)__builtin_amdgcn_update_dpp(0, (int)__float_as_uint(v), 0x4E, 0xF, 0xF, false));
                            v += __uint_as_float((unsigned)__builtin_amdgcn_update_dpp(0, (int)__float_as_uint(v), 0x124, 0xF, 0xF, false)); v += __uint_as_float((unsigned)__builtin_amdgcn_update_dpp(0, (int)__float_as_uint(v), 0x128, 0xF, 0xF, false)); s[j] = v; }
                        if (fr == 0) *(f32x4*)(part + ((size_t)wr * 16 + g) * 8192 + col0 + bj * HALF + 4 * n) = s; }
            }
        }
    }
};
struct EpiQKU8 {
    static constexpr bool PERM = true, AFTER_DRAIN = false;
    bf16_t* O; const float* srow; const float* scol;
    __device__ __forceinline__ void operator()(const i32x4 (&acc)[2][2][4][2], const Unit& u, int wr, int wc, int fr, int fq) const {
        const int row0 = u.pm * BM + wr * 64 + fr; const int t = u.pn >> 3; const int colt = (u.pn & 7) * BM;
        bf16_t* base = O + (size_t)t * ((size_t)8192 * 2048); const int col0 = colt + wc * 32 + 8 * fq, gcol0 = u.pn * BM + wc * 32 + 8 * fq;
        f32x4 sc[2][2];
#pragma unroll
        for (int bj = 0; bj < 2; ++bj) { sc[bj][0] = *(const f32x4*)(scol + gcol0 + bj * HALF); sc[bj][1] = *(const f32x4*)(scol + gcol0 + bj * HALF + 4); }
#pragma unroll
        for (int ai = 0; ai < 2; ++ai)
#pragma unroll
            for (int m = 0; m < 4; ++m) { const int row = row0 + ai * HALF + m * 16; const float sr = srow[row]; bf16_t* rowp = base + (size_t)row * 2048 + col0;
#pragma unroll
                for (int bj = 0; bj < 2; ++bj) { f32x4 v0, v1;
#pragma unroll
                    for (int j = 0; j < 4; ++j) { v0[j] = (float)acc[ai][bj][m][0][j] * sr * sc[bj][0][j]; v1[j] = (float)acc[ai][bj][m][1][j] * sr * sc[bj][1][j]; }
                    if (t == 2) {
#pragma unroll
                        for (int j = 0; j < 4; ++j) { v0[j] = gelu_tanh(v0[j]); v1[j] = gelu_tanh(v1[j]); } }
                    u32x4 w; w.x = cvt_pk_bf16(v0[0], v0[1]); w.y = cvt_pk_bf16(v0[2], v0[3]); w.z = cvt_pk_bf16(v1[0], v1[1]); w.w = cvt_pk_bf16(v1[2], v1[3]);
                    *(u32x4*)(rowp + bj * HALF) = w; } }
    }
};
struct EpiVT8 {
    static constexpr bool PERM = true, AFTER_DRAIN = false;
    bf16_t* O; float* part; const float* srow; const float* scol;
    __device__ __forceinline__ void operator()(const i32x4 (&acc)[2][2][4][2], const Unit& u, int wr, int wc, int fr, int fq) const {
        const int row0 = u.pm * BM + wr * 64 + fr, col0 = u.pn * BM + wc * 32 + 8 * fq; const bool sg = u.pm >= 8;
        f32x4 sc[2][2];
#pragma unroll
        for (int bj = 0; bj < 2; ++bj) { sc[bj][0] = *(const f32x4*)(scol + col0 + bj * HALF); sc[bj][1] = *(const f32x4*)(scol + col0 + bj * HALF + 4); }
#pragma unroll
        for (int ai = 0; ai < 2; ++ai) {
            f32x4 cs[2][2];
#pragma unroll
            for (int bj = 0; bj < 2; ++bj) { cs[bj][0] = (f32x4){0.f, 0.f, 0.f, 0.f}; cs[bj][1] = (f32x4){0.f, 0.f, 0.f, 0.f}; }
#pragma unroll
            for (int m = 0; m < 4; ++m) { const int row = row0 + ai * HALF + m * 16; const float sr = srow[row]; bf16_t* rowp = O + (size_t)row * 8192 + col0;
#pragma unroll
                for (int bj = 0; bj < 2; ++bj) { f32x4 v0, v1;
#pragma unroll
                    for (int j = 0; j < 4; ++j) { v0[j] = (float)acc[ai][bj][m][0][j] * sr * sc[bj][0][j]; v1[j] = (float)acc[ai][bj][m][1][j] * sr * sc[bj][1][j]; }
                    if (sg) {
#pragma unroll
                        for (int j = 0; j < 4; ++j) { v0[j] = gelu_tanh(v0[j]); v1[j] = gelu_tanh(v1[j]); }
                        cs[bj][0] += v0 * v0; cs[bj][1] += v1 * v1; }
                    u32x4 w; w.x = cvt_pk_bf16(v0[0], v0[1]); w.y = cvt_pk_bf16(v0[2], v0[3]); w.z = cvt_pk_bf16(v1[0], v1[1]); w.w = cvt_pk_bf16(v1[2], v1[3]);
                    *(u32x4*)(rowp + bj * HALF) = w; } }
            if (sg) {
                const int g = (u.pm - 8) * 2 + ai;
#pragma unroll
                for (int bj = 0; bj < 2; ++bj)
#pragma unroll
                    for (int n = 0; n < 2; ++n) { f32x4 s = cs[bj][n];
#pragma unroll
                        for (int j = 0; j < 4; ++j) { float v = s[j];
                            v += __uint_as_float((unsigned)__builtin_amdgcn_update_dpp(0, (int)__float_as_uint(v), 0xB1, 0xF, 0xF, false)); v += __uint_as_float((unsigned)__builtin_amdgcn_update_dpp(0, (int)__float_as_uint(v), 0x4E, 0xF, 0xF, false));
                            v += __uint_as_float((unsigned)__builtin_amdgcn_update_dpp(0, (int)__float_as_uint(v), 0x124, 0xF, 0xF, false)); v += __uint_as_float((unsigned)__builtin_amdgcn_update_dpp(0, (int)__float_as_uint(v), 0x128, 0xF, 0xF, false)); s[j] = v; }
                        if (fr == 0) *(f32x4*)(part + ((size_t)wr * 16 + g) * 8192 + col0 + bj * HALF + 4 * n) = s; }
            }
        }
    }
};
struct EpiH {
    static constexpr bool PERM = true, AFTER_DRAIN = false;
    const float* x; bf16_t* hb; float* hss;
    __device__ __forceinline__ void operator()(const f32x4 (&acc)[2][2][4][2], const Unit& u, int wr, int wc, int fr, int fq) const {
        const int row0 = u.pm * BM + wr * 64 + fr, col0 = u.pn * BM + wc * 32 + 8 * fq;
#pragma unroll
        for (int ai = 0; ai < 2; ++ai)
#pragma unroll
            for (int m = 0; m < 4; ++m) { const int row = row0 + ai * HALF + m * 16; const size_t off = (size_t)row * 4096 + col0; float ss = 0.f;
#pragma unroll
                for (int bj = 0; bj < 2; ++bj) { const f32x4 x0 = *(const f32x4*)(x + off + bj * HALF), x1 = *(const f32x4*)(x + off + bj * HALF + 4);
                    const f32x4 h0 = x0 + acc[ai][bj][m][0], h1 = x1 + acc[ai][bj][m][1];
                    ss += (h0[0] * h0[0] + h0[1] * h0[1]) + (h0[2] * h0[2] + h0[3] * h0[3]) + (h1[0] * h1[0] + h1[1] * h1[1]) + (h1[2] * h1[2] + h1[3] * h1[3]);
                    u32x4 w; w.x = cvt_pk_bf16(h0[0], h0[1]); w.y = cvt_pk_bf16(h0[2], h0[3]); w.z = cvt_pk_bf16(h1[0], h1[1]); w.w = cvt_pk_bf16(h1[2], h1[3]);
                    *(u32x4*)(hb + off + bj * HALF) = w; }
                ss += __shfl_xor(ss, 16); ss += __shfl_xor(ss, 32);
                if (fq == 0) hss[(size_t)(u.pn * 4 + wc) * 8192 + row] = ss;
                if (m == 3) asm volatile("" ::: "memory"); }
    }
};
struct EpiH8 {
    static constexpr bool PERM = true, AFTER_DRAIN = false;
    const float* x; bf16_t* hb; float* hss; const float* srow; const float* scol;
    __device__ __forceinline__ void operator()(const i32x4 (&acc)[2][2][4][2], const Unit& u, int wr, int wc, int fr, int fq) const {
        const int row0 = u.pm * BM + wr * 64 + fr, col0 = u.pn * BM + wc * 32 + 8 * fq;
        f32x4 sc[2][2];
#pragma unroll
        for (int bj = 0; bj < 2; ++bj) { sc[bj][0] = *(const f32x4*)(scol + col0 + bj * HALF); sc[bj][1] = *(const f32x4*)(scol + col0 + bj * HALF + 4); }
#pragma unroll
        for (int ai = 0; ai < 2; ++ai)
#pragma unroll
            for (int m = 0; m < 4; ++m) { const int row = row0 + ai * HALF + m * 16; const size_t off = (size_t)row * 4096 + col0; float ss = 0.f; const float sr = srow[row];
#pragma unroll
                for (int bj = 0; bj < 2; ++bj) { const f32x4 x0 = *(const f32x4*)(x + off + bj * HALF), x1 = *(const f32x4*)(x + off + bj * HALF + 4);
                    f32x4 h0, h1;
#pragma unroll
                    for (int j = 0; j < 4; ++j) { h0[j] = x0[j] + (float)acc[ai][bj][m][0][j] * sr * sc[bj][0][j]; h1[j] = x1[j] + (float)acc[ai][bj][m][1][j] * sr * sc[bj][1][j]; }
                    ss += (h0[0] * h0[0] + h0[1] * h0[1]) + (h0[2] * h0[2] + h0[3] * h0[3]) + (h1[0] * h1[0] + h1[1] * h1[1]) + (h1[2] * h1[2] + h1[3] * h1[3]);
                    u32x4 w; w.x = cvt_pk_bf16(h0[0], h0[1]); w.y = cvt_pk_bf16(h0[2], h0[3]); w.z = cvt_pk_bf16(h1[0], h1[1]); w.w = cvt_pk_bf16(h1[2], h1[3]);
                    *(u32x4*)(hb + off + bj * HALF) = w; }
                ss += __shfl_xor(ss, 16); ss += __shfl_xor(ss, 32);
                if (fq == 0) hss[(size_t)(u.pn * 4 + wc) * 8192 + row] = ss;
                if (m == 3) asm volatile("" ::: "memory"); }
    }
};
struct EpiF32 {
    static constexpr bool PERM = false, AFTER_DRAIN = false;
    float* C; int ldc;
    __device__ __forceinline__ void operator()(const f32x4 (&acc)[2][2][4][2], const Unit& u, int wr, int wc, int fr, int fq) const {
        const int row0 = u.pm * BM + wr * 64 + fr, col0 = u.pn * BM + wc * 32 + 4 * fq;
#pragma unroll
        for (int ai = 0; ai < 2; ++ai)
#pragma unroll
            for (int m = 0; m < 4; ++m) { float* rowp = C + (size_t)(row0 + ai * HALF + m * 16) * ldc + col0;
#pragma unroll
                for (int bj = 0; bj < 2; ++bj)
#pragma unroll
                    for (int n = 0; n < 2; ++n) *(f32x4*)(rowp + bj * HALF + n * 16) = acc[ai][bj][m][n]; }
    }
};

template <class Epi, class Sched, bool ALIGN_EPI = false, bool SP2 = false, bool I8 = false>
__device__ __forceinline__ void gemm_phase(PG8_LAS unsigned char* lds, const Gemm g, const Sched& S, const Epi& E) {
    const int tid = threadIdx.x, wid = __builtin_amdgcn_readfirstlane(tid >> 6), lane = tid & 63, wr = wid >> 2, wc = wid & 3, fr = lane & 15, fq = lane >> 4;
    const int K = g.K, nt = K / BK;
    unsigned voffA[2], voffB[2];
#pragma unroll
    for (int i = 0; i < 2; ++i) { int R, C; stage_rc(tid * 16 + i * 8192, R, C); const int Rb = Epi::PERM ? ((R & ~31) + perm32(R & 31)) : R;
        voffA[i] = (unsigned)(R * K + C) * 2u; voffB[i] = (unsigned)(Rb * K + C) * 2u; }
    const size_t kstep = (size_t)(BK * 2);
    const size_t hstep = (size_t)HALF * K * 2;
    const size_t tstep = 2 * hstep;
    const unsigned ldsw = (unsigned)wid * 1024u;
    const int aoff = lds_byte(wr * 64 + fr, fq * 8), boff = lds_byte(wc * 32 + fr, fq * 8);
#define PG8_SA(b, h) (((b) * 2 + (h)) * HTB)
#define PG8_SB(b, h) ((4 + (b) * 2 + (h)) * HTB)
#define PG8_STAGE(bufoff, gbase, voff) do { _Pragma("unroll") for (int _i = 0; _i < 2; ++_i) \
        __builtin_amdgcn_global_load_lds((const unsigned*)((const char*)(gbase) + (voff)[_i]), (PG8_LAS unsigned*)(lds + (bufoff) + ldsw + _i * 8192), 16, 0, 0); } while (0)
#define PG8_LDA(dst, b, h) do { _Pragma("unroll") for (int m = 0; m < 4; ++m) _Pragma("unroll") for (int k = 0; k < 2; ++k) dst[m][k] = *(const PG8_LAS bf16x8*)(lds + PG8_SA(b, h) + aoff + m * 2048 + k * 1024); } while (0)
#define PG8_LDB(dst, b, h) do { _Pragma("unroll") for (int n = 0; n < 2; ++n) _Pragma("unroll") for (int k = 0; k < 2; ++k) dst[n][k] = *(const PG8_LAS bf16x8*)(lds + PG8_SB(b, h) + boff + n * 2048 + k * 1024); } while (0)
#define PG8_MMA(ai, bj, At, Bt) do { __builtin_amdgcn_s_setprio(1); _Pragma("unroll") for (int m = 0; m < 4; ++m) _Pragma("unroll") for (int n = 0; n < 2; ++n) _Pragma("unroll") for (int k = 0; k < 2; ++k) { \
        if constexpr (I8) acc[ai][bj][m][n] = __builtin_amdgcn_mfma_i32_16x16x64_i8(__builtin_bit_cast(i32x4, Bt[n][k]), __builtin_bit_cast(i32x4, At[m][k]), acc[ai][bj][m][n], 0, 0, 0); \
        else acc[ai][bj][m][n] = __builtin_amdgcn_mfma_f32_16x16x32_bf16(Bt[n][k], At[m][k], acc[ai][bj][m][n], 0, 0, 0); } __builtin_amdgcn_s_setprio(0); } while (0)
#define PG8_WAIT_V(n) asm volatile("s_waitcnt vmcnt(" #n ")" ::: "memory")
#define PG8_WAIT_L(n) asm volatile("s_waitcnt lgkmcnt(" #n ")" ::: "memory")
#define PG8_BAR __builtin_amdgcn_s_barrier()
#define PG8_SCHED __builtin_amdgcn_sched_barrier(0)
    Unit cur, nxt; int ui = 0;
    if (!S.next(0, cur)) return;
    typedef typename AccT<I8>::type acc_t;
    acc_t acc[2][2][4][2];
#pragma unroll
    for (int a = 0; a < 2; ++a)
#pragma unroll
        for (int b = 0; b < 2; ++b)
#pragma unroll
            for (int m = 0; m < 4; ++m)
#pragma unroll
                for (int n = 0; n < 2; ++n) acc[a][b][m][n] = (acc_t){0, 0, 0, 0};
    bf16x8 At[4][2], B0[2][2], B1[2][2];
    const char* cA = (const char*)g.A + (size_t)cur.pm * tstep; const char* cB = (const char*)g.Bt + (size_t)cur.pn * tstep;
    S.a_ready(cur);
    if constexpr (SP2) {
        PG8_STAGE(PG8_SB(0, 0), cB, voffB); PG8_STAGE(PG8_SB(0, 1), cB + hstep, voffB); PG8_STAGE(PG8_SA(0, 0), cA, voffA); PG8_STAGE(PG8_SA(0, 1), cA + hstep, voffA);
        if (wr == 1) PG8_BAR;
        PG8_WAIT_V(2); PG8_BAR;
        PG8_STAGE(PG8_SB(1, 0), cB + kstep, voffB); PG8_STAGE(PG8_SA(1, 0), cA + kstep, voffA); PG8_STAGE(PG8_SB(1, 1), cB + hstep + kstep, voffB);
        PG8_WAIT_V(6); PG8_BAR;
    } else {
        PG8_STAGE(PG8_SB(0, 0), cB, voffB); PG8_STAGE(PG8_SA(0, 0), cA, voffA); PG8_STAGE(PG8_SB(0, 1), cB + hstep, voffB); PG8_STAGE(PG8_SA(0, 1), cA + hstep, voffA);
        if (wr == 1) PG8_BAR;
        PG8_WAIT_V(4); PG8_BAR;
        PG8_STAGE(PG8_SB(1, 0), cB + kstep, voffB); PG8_STAGE(PG8_SA(1, 0), cA + kstep, voffA); PG8_STAGE(PG8_SB(1, 1), cB + hstep + kstep, voffB);
        PG8_WAIT_V(6); PG8_BAR;
    }
    for (;;) {
        const bool has_next = S.next(ui + 1, nxt);
        const char* nA = has_next ? (const char*)g.A + (size_t)nxt.pm * tstep : cA; const char* nB = has_next ? (const char*)g.Bt + (size_t)nxt.pn * tstep : cB;
        for (int t = 0; t < nt; t += 2) {
            const bool last = (t == nt - 2);
            const char* a1 = cA + (size_t)(t + 1) * kstep;
            const char* a2 = last ? nA : cA + (size_t)(t + 2) * kstep; const char* b2 = last ? nB : cB + (size_t)(t + 2) * kstep;
            const char* a3 = a2 + kstep; const char* b3 = b2 + kstep;
            if (last && has_next) S.a_ready(nxt);
            if constexpr (SP2) {
            PG8_LDB(B0, 0, 0); PG8_LDB(B1, 0, 1); PG8_SCHED; PG8_LDA(At, 0, 0); PG8_STAGE(PG8_SA(1, 1), a1 + hstep, voffA);
            PG8_WAIT_V(8); PG8_WAIT_L(0); PG8_BAR; PG8_MMA(0, 0, At, B0); PG8_MMA(0, 1, At, B1); PG8_BAR; PG8_SCHED;
            PG8_LDA(At, 0, 1); PG8_STAGE(PG8_SB(0, 0), b2, voffB); PG8_STAGE(PG8_SB(0, 1), b2 + hstep, voffB); PG8_STAGE(PG8_SA(0, 0), a2, voffA);
            PG8_WAIT_V(8); PG8_WAIT_L(0); PG8_BAR; PG8_MMA(1, 0, At, B0); PG8_MMA(1, 1, At, B1); PG8_BAR; PG8_SCHED;
            PG8_LDB(B0, 1, 0); PG8_LDB(B1, 1, 1); PG8_SCHED; PG8_LDA(At, 1, 0); PG8_STAGE(PG8_SA(0, 1), a2 + hstep, voffA);
            PG8_WAIT_V(8); PG8_WAIT_L(0); PG8_BAR; PG8_MMA(0, 0, At, B0); PG8_MMA(0, 1, At, B1); PG8_BAR; PG8_SCHED;
            PG8_LDA(At, 1, 1); PG8_STAGE(PG8_SB(1, 0), b3, voffB); PG8_STAGE(PG8_SB(1, 1), b3 + hstep, voffB); PG8_STAGE(PG8_SA(1, 0), a3, voffA);
            PG8_WAIT_V(8); PG8_WAIT_L(0); PG8_BAR; PG8_MMA(1, 0, At, B0); PG8_MMA(1, 1, At, B1); PG8_BAR; PG8_SCHED;
            } else {
            PG8_LDB(B0, 0, 0); PG8_SCHED; PG8_LDA(At, 0, 0); PG8_STAGE(PG8_SA(1, 1), a1 + hstep, voffA);
            PG8_WAIT_L(8); PG8_BAR; PG8_WAIT_L(0); PG8_MMA(0, 0, At, B0); PG8_BAR; PG8_SCHED;
            PG8_LDB(B1, 0, 1); PG8_STAGE(PG8_SB(0, 0), b2, voffB);
            PG8_BAR; PG8_WAIT_L(0); PG8_MMA(0, 1, At, B1); PG8_BAR;
            PG8_LDA(At, 0, 1); PG8_STAGE(PG8_SA(0, 0), a2, voffA);
            PG8_BAR; PG8_WAIT_L(0); PG8_MMA(1, 0, At, B0); PG8_BAR; PG8_SCHED;
            PG8_STAGE(PG8_SB(0, 1), b2 + hstep, voffB);
            PG8_WAIT_V(6); PG8_BAR; PG8_MMA(1, 1, At, B1); PG8_BAR;
            PG8_LDB(B0, 1, 0); PG8_SCHED; PG8_LDA(At, 1, 0); PG8_STAGE(PG8_SA(0, 1), a2 + hstep, voffA);
            PG8_WAIT_L(8); PG8_BAR; PG8_WAIT_L(0); PG8_MMA(0, 0, At, B0); PG8_BAR; PG8_SCHED;
            PG8_LDB(B1, 1, 1); PG8_STAGE(PG8_SB(1, 0), b3, voffB);
            PG8_BAR; PG8_WAIT_L(0); PG8_MMA(0, 1, At, B1); PG8_BAR;
            PG8_LDA(At, 1, 1); PG8_STAGE(PG8_SA(1, 0), a3, voffA);
            PG8_BAR; PG8_WAIT_L(0); PG8_MMA(1, 0, At, B0); PG8_BAR; PG8_SCHED;
            PG8_STAGE(PG8_SB(1, 1), b3 + hstep, voffB);
            PG8_WAIT_V(6); PG8_BAR; PG8_MMA(1, 1, At, B1); PG8_BAR;
            }
        }
        if constexpr (ALIGN_EPI) { if (wr == 0) PG8_BAR; }
        if constexpr (!Epi::AFTER_DRAIN) { E(acc, cur, wr, wc, fr, fq); S.done(cur); }
        if (!has_next) break;
#pragma unroll
        for (int a = 0; a < 2; ++a)
#pragma unroll
            for (int b = 0; b < 2; ++b)
#pragma unroll
                for (int m = 0; m < 4; ++m)
#pragma unroll
                    for (int n = 0; n < 2; ++n) acc[a][b][m][n] = (acc_t){0, 0, 0, 0};
        cur = nxt; cA = nA; cB = nB; ++ui;
        if constexpr (ALIGN_EPI) { if (wr == 1) PG8_BAR; }
    }
    PG8_WAIT_V(0);
    if constexpr (!ALIGN_EPI) { if (wr == 0) PG8_BAR; }
    PG8_BAR;
#undef PG8_SA
#undef PG8_SB
#undef PG8_STAGE
#undef PG8_LDA
#undef PG8_LDB
#undef PG8_MMA
#undef PG8_WAIT_V
#undef PG8_WAIT_L
#undef PG8_BAR
#undef PG8_SCHED
}
}

constexpr int NWAVES = 8;
constexpr int N_LAUNCHES = MK_N_LAUNCHES; static_assert(N_LAUNCHES == 1, "one launch");
constexpr int PER_PHASE = 6;
constexpr int T = 8192, DM = 4096, SBW = 2048, NHEAD = 16, HD = 128, NGRP = 16;
constexpr int NA = 6144, MB = 4096;
constexpr int PH = 8, PNK = 128, PHALF = 256, PK = 16, NEXP = 16384, NSC = 2048;
constexpr float EPS = 1e-6f;
constexpr float ATT_EXIT = 160.0f;
constexpr float QSCALE = 0.08838834764831845f * 1.4426950408889634f;

constexpr size_t MiB = 1u << 20;
constexpr size_t WS_CTL = 0, CTL_ZERO_BYTES = 1 * MiB;
constexpr size_t WS_XN = 1 * MiB;
constexpr size_t WS_WA = 65 * MiB;
constexpr size_t WS_WB = 113 * MiB;
constexpr size_t WS_WO = 145 * MiB;
constexpr size_t WS_WS = 177 * MiB;
constexpr size_t WS_QKU = 193 * MiB;
constexpr size_t WS_VG = 289 * MiB;
constexpr size_t WS_GVP = 353 * MiB;
constexpr size_t WS_MIX = 354 * MiB;
constexpr size_t WS_HB = 418 * MiB;
constexpr size_t WS_HSS = 482 * MiB;
constexpr size_t WS_SC = 484 * MiB;
constexpr int TROW = 2048;
static_assert((size_t)16384 * TROW <= 36 * MiB, "table size");
constexpr size_t WS_UT = 548 * MiB;
constexpr size_t WS_VT = 584 * MiB;
constexpr size_t WS_MIXQ = 33 * MiB;
constexpr size_t WS_SCL = 620 * MiB;
constexpr size_t WS_END = 621 * MiB;
constexpr int CW_TMO = 0, CW_CODE = 1, CW_TOK = 2, CW_SCMAX = 64;
constexpr int CW_BAR = 4096;

constexpr int RING_OFF = 0, RING_BYTES = 131072;
constexpr int P5_LIST_OFF = 147456;
constexpr int LDSCTL_OFF = 155648, MISC_OFF = LDSCTL_OFF + 320;
constexpr int LDS_BYTES = 163840;

#define GAS __attribute__((address_space(1)))
#define LAS __attribute__((address_space(3)))
#define DI __device__ __forceinline__
typedef unsigned short bf16;
typedef unsigned v4u __attribute__((ext_vector_type(4)));
typedef unsigned v2u __attribute__((ext_vector_type(2)));
typedef float f32x4 __attribute__((ext_vector_type(4)));
typedef float f32x2 __attribute__((ext_vector_type(2)));
typedef float f32x16 __attribute__((ext_vector_type(16)));
typedef short bf16x8 __attribute__((ext_vector_type(8)));
typedef __bf16 bf16x2_t __attribute__((ext_vector_type(2)));
typedef GAS unsigned gu32;
#define RLX_AGENT __ATOMIC_RELAXED, __HIP_MEMORY_SCOPE_AGENT
#define LDS_WAIT() asm volatile("s_waitcnt lgkmcnt(0)" ::: "memory")
#define VM_WAIT() asm volatile("s_waitcnt vmcnt(0)" ::: "memory")
#define MFMA32(a, b, c) __builtin_amdgcn_mfma_f32_32x32x16_bf16((a), (b), (c), 0, 0, 0)

DI unsigned f2bf(float f) { unsigned u = __builtin_bit_cast(unsigned, f); return (u + 0x7fffu + ((u >> 16) & 1u)) >> 16; }
DI unsigned pk2(float lo, float hi) { f32x2 v = {lo, hi}; bf16x2_t b = __builtin_convertvector(v, bf16x2_t); return __builtin_bit_cast(unsigned, b); }
DI float bflo(unsigned u) { return __uint_as_float(u << 16); }
DI float bfhi(unsigned u) { return __uint_as_float(u & 0xffff0000u); }
DI int crow(int i, int h) { return (i & 3) + 8 * (i >> 2) + 4 * h; }
DI float swap_add(float x) { auto rr = __builtin_amdgcn_permlane32_swap(__float_as_uint(x), __float_as_uint(x), false, false); return __uint_as_float(rr[0]) + __uint_as_float(rr[1]); }
DI float dot2bf(unsigned a, unsigned b, float c) { return __builtin_amdgcn_fdot2_f32_bf16(__builtin_bit_cast(bf16x2_t, a), __builtin_bit_cast(bf16x2_t, b), c, false); }
DI bf16x8 pack8(float a0, float a1, float a2, float a3, float a4, float a5, float a6, float a7) { v4u p; p.x = pk2(a0, a1); p.y = pk2(a2, a3); p.z = pk2(a4, a5); p.w = pk2(a6, a7); return __builtin_bit_cast(bf16x8, p); }
DI float wave_sum(float v) {
#pragma unroll
    for (int o = 1; o < 64; o <<= 1) v += __shfl_xor(v, o);
    return v;
}

template <int CTRL> DI float dpp_f2(float v) { return __uint_as_float((unsigned)__builtin_amdgcn_update_dpp(0, (int)__float_as_uint(v), CTRL, 0xF, 0xF, false)); }
#define XB_TMO      128
#define XB_XCNT(j)  (256  + 64 * (j))
#define XB_XSUB(j)  (1280 + 64 * (j))
#define XB_XGEN(j)  (2304 + 64 * (j))
#define XB_TOP      3328
#define XB_TOPGEN   3392
#define XCD_BAR_WORDS 3456
#define XB_SPIN_CAP (1u << 18)
DI unsigned xb_ld(unsigned* p)              { return __hip_atomic_load(p, __ATOMIC_RELAXED, __HIP_MEMORY_SCOPE_AGENT); }
DI unsigned xb_add(unsigned* p, unsigned v) { return __hip_atomic_fetch_add(p, v, __ATOMIC_RELAXED, __HIP_MEMORY_SCOPE_AGENT); }
DI unsigned xb_xcc_id() { return (unsigned)__builtin_amdgcn_s_getreg((3 << 11) | 20) & 0xFu; }
#define XB_SPIN(cond, bar) do { unsigned _sp = 0; while (cond) { __builtin_amdgcn_s_sleep(1); \
    if ((++_sp & 255u) == 0u) { if (xb_ld(&(bar)[XB_TMO])) break; if (_sp > XB_SPIN_CAP) { atomicAdd(&(bar)[XB_TMO], 1u); break; } } } } while (0)
struct XcdBarrier { unsigned* bar; unsigned x; volatile LAS unsigned* st; };
DI XcdBarrier xcd_barrier_post(unsigned* bar, volatile LAS unsigned* st) {
    XcdBarrier b; b.bar = bar; b.x = xb_xcc_id(); b.st = st;
    if (threadIdx.x == 0) (void)xb_add(&bar[XB_XCNT(b.x)], 1u);
    return b;
}
DI void xcd_barrier_complete(unsigned* bar, unsigned x, unsigned& nloc, unsigned& nx) {
    const unsigned G = gridDim.x * gridDim.y * gridDim.z;
    unsigned sum, cnt, mine, sp = 0u;
    for (;;) {
        sum = 0u; cnt = 0u; mine = 0u;
#pragma unroll
        for (unsigned j = 0; j < 16; ++j) { const unsigned c = xb_ld(&bar[XB_XCNT(j)]); sum += c; cnt += (c > 0u) ? 1u : 0u; mine = (j == x) ? c : mine; }
        if (sum == G) break;
        __builtin_amdgcn_s_sleep(1);
        if ((++sp & 255u) == 0u) { if (xb_ld(&bar[XB_TMO])) break; if (sp > XB_SPIN_CAP) { atomicAdd(&bar[XB_TMO], 1u); break; } }
    }
    nloc = mine > 0u ? mine : 1u; nx = cnt > 0u ? cnt : 1u;
}
DI void xcd_barrier(const XcdBarrier& b) {
    asm volatile("s_waitcnt vmcnt(0)" ::: "memory");
    __syncthreads();
    if (threadIdx.x == 0) {
        unsigned* bar = b.bar;
        __builtin_amdgcn_s_waitcnt(0);
        unsigned nloc = b.st[0], nx = b.st[1];
        if (nloc == 0u) { xcd_barrier_complete(bar, b.x, nloc, nx); b.st[0] = nloc; b.st[1] = nx; }
        const unsigned old = xb_add(&bar[XB_XSUB(b.x)], 1u);
        const unsigned gen = old / nloc;
        if (old + 1u == (gen + 1u) * nloc) {
            __builtin_amdgcn_fence(__ATOMIC_RELEASE, "agent");
            asm volatile("s_waitcnt vmcnt(0)" ::: "memory");
            const unsigned og = xb_add(&bar[XB_TOP], 1u);
            const unsigned tg = og / nx;
            if (og + 1u == (tg + 1u) * nx) xb_add(&bar[XB_TOPGEN], 1u);
            else XB_SPIN(xb_ld(&bar[XB_TOPGEN]) == tg, bar);
            __builtin_amdgcn_fence(__ATOMIC_ACQUIRE, "agent");
            xb_add(&bar[XB_XGEN(b.x)], 1u);
            asm volatile("s_waitcnt vmcnt(0)" ::: "memory");
        } else {
            XB_SPIN(xb_ld(&bar[XB_XGEN(b.x)]) == gen, bar);
            __builtin_amdgcn_fence(__ATOMIC_ACQUIRE, "agent");
            asm volatile("s_waitcnt vmcnt(0)" ::: "memory");
        }
    }
    __syncthreads();
}

struct Frame {
    LAS unsigned char* lds;
    volatile LAS unsigned* MISC;
    gu32* ctl;
    int tid, lane, wave;
    int vcu, G;
    const float *x, *mix_g, *w_in, *q_g, *k_g, *sgu_vg, *sgu_w, *sgu_b, *sb_og, *sgu_og, *w_out, *ffn_g, *w_q, *keys, *pu, *pv;
    float* out;
    unsigned char *XN, *WA, *WB, *MIXQ, *WO;
    float *SA, *SWA, *SWB, *SA2, *SWO;
    bf16 *WS, *QKU, *VG, *MIX, *HB;
    unsigned char *UT, *VT;
    float *GVP, *HSS, *SC, *USC, *VSC;
};

DI void rms_row_to_i8(const float* xrow, const f32x4 (&gr)[16], unsigned char* orow, float* scale, int lane) {
    const GAS f32x4* xr = (const GAS f32x4*)xrow + lane;
    f32x4 v[16]; float s = 0.f;
#pragma unroll
    for (int j = 0; j < 16; ++j) { v[j] = __builtin_nontemporal_load(xr + 64 * j); s += (v[j].x * v[j].x + v[j].y * v[j].y) + (v[j].z * v[j].z + v[j].w * v[j].w); }
    const float rstd = __builtin_amdgcn_rsqf(wave_sum(s) * (1.f / DM) + EPS);
    float m = 0.f;
#pragma unroll
    for (int j = 0; j < 16; ++j) { v[j] = v[j] * gr[j] * rstd;
        m = __builtin_fmaxf(__builtin_fmaxf(m, __builtin_fmaxf(__builtin_fabsf(v[j].x), __builtin_fabsf(v[j].y))), __builtin_fmaxf(__builtin_fabsf(v[j].z), __builtin_fabsf(v[j].w))); }
#pragma unroll
    for (int o = 1; o < 64; o <<= 1) m = __builtin_fmaxf(m, __shfl_xor(m, o));
    const float inv = m > 0.f ? 127.0f / m : 0.f;
    GAS unsigned* o4 = (GAS unsigned*)orow + lane;
#pragma unroll
    for (int j = 0; j < 16; ++j) { const int q0 = (int)__builtin_rintf(v[j].x * inv), q1 = (int)__builtin_rintf(v[j].y * inv), q2 = (int)__builtin_rintf(v[j].z * inv), q3 = (int)__builtin_rintf(v[j].w * inv);
        o4[64 * j] = (unsigned)(q0 & 255) | ((unsigned)(q1 & 255) << 8) | ((unsigned)(q2 & 255) << 16) | ((unsigned)(q3 & 255) << 24); }
    if (lane == 0) *scale = m * (1.0f / 127.0f);
}
DI void p0_strip(Frame& F, const float* W, int N, int n0, unsigned char* dst_row0, float* scale_row0, LAS unsigned char* wl  , LAS float* xm  ) {
    const int lane = F.lane, c = lane & 31, p = lane >> 5, w = F.wave;
    const float* src = W + (size_t)(512 * w + p) * N + n0 + c;
    const size_t rstep = (size_t)2 * N;
    unsigned pk[128]; float m = 0.f;
#pragma unroll
    for (int i0 = 0; i0 < 256; i0 += 32) { float t[32];
#pragma unroll
        for (int j = 0; j < 32; ++j) { t[j] = __builtin_nontemporal_load(src); src += rstep; }
#pragma unroll
        for (int j = 0; j < 32; j += 2) { m = __builtin_fmaxf(m, __builtin_fmaxf(__builtin_fabsf(t[j]), __builtin_fabsf(t[j + 1]))); pk[(i0 + j) >> 1] = pk2(t[j], t[j + 1]); asm volatile("" : "+v"(pk[(i0 + j) >> 1])); }
        asm volatile("" ::: "memory"); }
    { auto rr = __builtin_amdgcn_permlane32_swap(__float_as_uint(m), __float_as_uint(m), false, false); m = __builtin_fmaxf(__uint_as_float(rr[0]), __uint_as_float(rr[1])); }
    if (lane < 32) xm[w * 32 + c] = m;
    __syncthreads();
    float cm = 0.f;
#pragma unroll
    for (int ww = 0; ww < 8; ++ww) cm = __builtin_fmaxf(cm, xm[ww * 32 + c]);
    const float inv = cm > 0.f ? 127.0f / cm : 0.f;
    if (w == 0 && lane < 32) scale_row0[c] = cm * (1.0f / 127.0f);
    unsigned d[64];
#pragma unroll
    for (int j = 0; j < 64; ++j) { const unsigned a = pk[2 * j], b = pk[2 * j + 1];
        const int q0 = (int)__builtin_rintf(bflo(a) * inv), q1 = (int)__builtin_rintf(bfhi(a) * inv), q2 = (int)__builtin_rintf(bflo(b) * inv), q3 = (int)__builtin_rintf(bfhi(b) * inv);
        d[j] = (unsigned)(q0 & 255) | ((unsigned)(q1 & 255) << 8) | ((unsigned)(q2 & 255) << 16) | ((unsigned)(q3 & 255) << 24); asm volatile("" : "+v"(d[j])); }
    LAS unsigned char* myrow = wl + c * 528 + 256 * p;
#pragma unroll
    for (int tq = 0; tq < 16; ++tq) { v4u o;
        { auto rr = __builtin_amdgcn_permlane32_swap(d[2 * tq], d[2 * tq + 32], false, false); const unsigned E = rr[0], O = rr[1];
          o.x = __builtin_amdgcn_perm(O, E, 0x05010400u); o.y = __builtin_amdgcn_perm(O, E, 0x07030602u); }
        { auto rr = __builtin_amdgcn_permlane32_swap(d[2 * tq + 1], d[2 * tq + 33], false, false); const unsigned E = rr[0], O = rr[1];
          o.z = __builtin_amdgcn_perm(O, E, 0x05010400u); o.w = __builtin_amdgcn_perm(O, E, 0x07030602u); }
        *(LAS v4u*)(myrow + 16 * tq) = o; }
    asm volatile("s_waitcnt lgkmcnt(0)" ::: "memory");
#pragma unroll
    for (int i = 0; i < 16; ++i) { const int row = 2 * i + p; const v4u v = *(const LAS v4u*)(wl + row * 528 + 16 * c);
        *(GAS v4u*)(dst_row0 + (size_t)row * DM + 512 * w + 16 * c) = v; }
    __syncthreads();
}
DI void p0_ws_unit(Frame& F, int unit) {
    const int hp = unit >> 4, grp = unit & 15, lane = F.lane, r = lane & 31, h = lane >> 5;
    LAS unsigned char* kl = F.lds + RING_OFF;
    __syncthreads();
    for (int f = F.wave; f < 64; f += NWAVES) { const int nb = f >> 4, sft = f & 15;
        const float* bp = F.keys + ((size_t)hp * 128 + nb * 32 + r) * 256 + 16 * sft + 8 * h;
        const f32x4 b0 = *(const f32x4*)bp, b1 = *(const f32x4*)(bp + 4);
        *(LAS bf16x8*)(kl + f * 1024 + lane * 16) = pack8(b0.x, b0.y, b0.z, b0.w, b1.x, b1.y, b1.z, b1.w); }
    __syncthreads();
    const int dblk = grp * 8 + F.wave;
    const float* ap = F.w_q + (size_t)(dblk * 32 + r) * DM + hp * 256 + 8 * h;
    f32x16 d[4];
#pragma unroll
    for (int nb = 0; nb < 4; ++nb)
#pragma unroll
        for (int i = 0; i < 16; ++i) d[nb][i] = 0.f;
    f32x4 av[16][2];
#pragma unroll
    for (int sft = 0; sft < 16; ++sft) { av[sft][0] = *(const f32x4*)(ap + 16 * sft); av[sft][1] = *(const f32x4*)(ap + 16 * sft + 4); }
#pragma unroll
    for (int sft = 0; sft < 16; ++sft) {
        const bf16x8 af = pack8(av[sft][0].x, av[sft][0].y, av[sft][0].z, av[sft][0].w, av[sft][1].x, av[sft][1].y, av[sft][1].z, av[sft][1].w);
#pragma unroll
        for (int nb = 0; nb < 4; ++nb) d[nb] = MFMA32(af, *(const LAS bf16x8*)(kl + (nb * 16 + sft) * 1024 + lane * 16), d[nb]);
    }
#pragma unroll
    for (int m = 0; m < 4; ++m) { const int dd = dblk * 32 + 8 * m + 4 * h; const f32x4 g = *(const f32x4*)(F.ffn_g + dd);
#pragma unroll
        for (int nb = 0; nb < 4; ++nb) { v2u o; o.x = pk2(d[nb][4 * m] * g.x, d[nb][4 * m + 1] * g.y); o.y = pk2(d[nb][4 * m + 2] * g.z, d[nb][4 * m + 3] * g.w);
            *(GAS v2u*)(F.WS + (size_t)(hp * 128 + nb * 32 + r) * DM + dd) = o; } }
}
DI void p0_prologue(Frame& F) {
    const int gw = F.vcu * NWAVES + F.wave, NGW = F.G * NWAVES;
    { f32x4 gr[16];
#pragma unroll
      for (int j = 0; j < 16; ++j) gr[j] = ((const GAS f32x4*)F.mix_g)[F.lane + 64 * j];
      for (int m = gw; m < T; m += NGW) rms_row_to_i8(F.x + (size_t)m * DM, gr, F.XN + (size_t)m * DM, F.SA + m, F.lane); }
    { constexpr int NIN = 10240, S_IN = NIN / 32, S_O = DM / 32; LAS float* xm = (LAS float*)(F.lds + P5_LIST_OFF);
      __syncthreads();
      for (int u = F.vcu; u < S_IN + S_O; u += F.G) {
          if (u < S_IN) { const int n0 = 32 * u, seg = n0 >> 11, within = n0 & 2047;
              const int drow = (seg == 0 || seg == 1) ? n0 : (seg == 2) ? within : (seg == 3) ? 4096 + within : 2048 + within; const bool toa = (seg == 0 || seg == 1 || seg == 3);
              p0_strip(F, F.w_in, NIN, n0, (toa ? F.WA : F.WB) + (size_t)drow * DM, (toa ? F.SWA : F.SWB) + drow, F.lds + F.wave * 18432, xm);
          } else { const int n0 = 32 * (u - S_IN);
              p0_strip(F, F.w_out, DM, n0, F.WO + (size_t)n0 * DM, F.SWO + n0, F.lds + F.wave * 18432, xm); } } }
    for (int unit = F.vcu; unit < 256; unit += F.G) p0_ws_unit(F, unit);
    __syncthreads();
}

template <int CTRL> DI unsigned dpp_u(unsigned v) { return (unsigned)__builtin_amdgcn_update_dpp(0, (int)v, CTRL, 0xF, 0xF, false); }
template <int CTRL> DI float dpp_f(float v) { return __uint_as_float(dpp_u<CTRL>(__float_as_uint(v))); }
DI unsigned umax(unsigned a, unsigned b) { return a > b ? a : b; }
DI unsigned umin(unsigned a, unsigned b) { return a < b ? a : b; }
DI unsigned row_umax(unsigned v) { v = umax(v, dpp_u<0xB1>(v)); v = umax(v, dpp_u<0x4E>(v)); v = umax(v, dpp_u<0x124>(v)); v = umax(v, dpp_u<0x128>(v)); return v; }
DI float row_fsum(float v) { v += dpp_f<0xB1>(v); v += dpp_f<0x4E>(v); v += dpp_f<0x124>(v); v += dpp_f<0x128>(v); return v; }
DI float rl_f(float v, int l) { return __uint_as_float((unsigned)__builtin_amdgcn_readlane((int)__float_as_uint(v), l)); }
DI float wave_fmax_u(float v) { v = __builtin_fmaxf(v, dpp_f<0xB1>(v)); v = __builtin_fmaxf(v, dpp_f<0x4E>(v)); v = __builtin_fmaxf(v, dpp_f<0x124>(v)); v = __builtin_fmaxf(v, dpp_f<0x128>(v));
    return __builtin_fmaxf(__builtin_fmaxf(rl_f(v, 0), rl_f(v, 16)), __builtin_fmaxf(rl_f(v, 32), rl_f(v, 48))); }
DI float wave_fsum_u(float v) { v = row_fsum(v); return (rl_f(v, 0) + rl_f(v, 16)) + (rl_f(v, 32) + rl_f(v, 48)); }
DI float xor16_f(float v) { return __uint_as_float((unsigned)__builtin_amdgcn_ds_swizzle((int)__float_as_uint(v), 0x401F)); }
DI void tq_load(const Frame& F, int row, int lane, f32x4 (&v)[16]) {
    const bool isv = row >= NEXP; const int e = isv ? row - NEXP : row;
    const GAS f32x4* src = (const GAS f32x4*)((isv ? F.pv : F.pu) + (size_t)e * DM) + lane;
#pragma unroll
    for (int j = 0; j < 16; ++j) v[j] = __builtin_nontemporal_load(src + 64 * j);
}
DI void tq_store(const Frame& F, int row, int lane, const f32x4 (&v)[16]) {
    const bool isv = row >= NEXP; const int e = isv ? row - NEXP : row;
    float ss = 0.f;
#pragma unroll
    for (int j = 0; j < 16; ++j) ss += (v[j].x * v[j].x + v[j].y * v[j].y) + (v[j].z * v[j].z + v[j].w * v[j].w);
    ss = wave_fsum_u(ss);
    const float step = 0.35f * __builtin_sqrtf(ss * (1.0f / DM)); const float inv = step > 0.f ? 1.0f / step : 0.f;
    constexpr float MAGIC = 12582912.0f + 8.0f; constexpr unsigned MBITS = 0x4B400000u, KSUB = MBITS * 0x11111111u;
    const unsigned flip = isv ? 0x80808080u : 0x88888888u;
    unsigned dw[8];
#pragma unroll
    for (int j = 0; j < 8; ++j) { unsigned w = 0u;
#pragma unroll
        for (int n = 0; n < 8; ++n) { const float x = v[2 * j + (n >> 2)][n & 3];
            const int sh = isv ? 4 * n : 4 * (n < 4 ? 2 * n : 2 * (n - 4) + 1);
            const float y = __builtin_amdgcn_fmed3f(__builtin_fmaf(x, inv, MAGIC), MAGIC - 7.0f, MAGIC + 7.0f); w += __float_as_uint(y) << sh; }
        dw[j] = (w - KSUB) ^ flip; }
    unsigned char* rowp = (isv ? F.VT : F.UT) + (size_t)e * TROW; GAS v4u* dst = (GAS v4u*)rowp + lane;
    v4u o0; o0.x = dw[0]; o0.y = dw[1]; o0.z = dw[2]; o0.w = dw[3]; v4u o1; o1.x = dw[4]; o1.y = dw[5]; o1.z = dw[6]; o1.w = dw[7];
    dst[0] = o0; dst[64] = o1;
    if (lane == 0) (isv ? F.VSC : F.USC)[e] = step;
}

DI void attn_dma_k(const unsigned char* tile  , LAS unsigned char* kbuf, unsigned koff) {
    asm volatile("" : "+v"(koff));
#pragma unroll
    for (int i = 0; i < 8; ++i)
        __builtin_amdgcn_global_load_lds((const unsigned*)(tile + (size_t)i * (4 * SBW * 2) + (koff ^ (64u * (i & 3)))), (LAS unsigned*)(kbuf + i * 1024), 16, 0, 0);
}
DI void attn_dma_v(const unsigned char* tile  , LAS unsigned char* vbuf, unsigned voff) {
    asm volatile("" : "+v"(voff));
#pragma unroll
    for (int i = 0; i < 8; ++i)
        __builtin_amdgcn_global_load_lds((const unsigned*)(tile + (size_t)i * (16 * T * 2) + voff), (LAS unsigned*)(vbuf + i * 1024), 16, 0, 0);
}
DI void stash_put(LAS unsigned char* st, int r, int h, int blk, int m, v2u p) { *(LAS v2u*)(st + r * 256 + (((4 * blk + m) ^ (r & 15)) << 4) + 8 * h) = p; }
DI void stash_store(const LAS unsigned char* st, bf16* gtile  , int ld, int lane, const float* gain  , float (&mx)[8]) {
    asm volatile("s_waitcnt lgkmcnt(0)" ::: "memory");
    const int c = lane & 15; const f32x4 g0 = *(const f32x4*)(gain + 8 * c), g1 = *(const f32x4*)(gain + 8 * c + 4);
#pragma unroll
    for (int i = 0; i < 8; ++i) { const int row = 4 * i + (lane >> 4);
        const v4u v = *(const LAS v4u*)(st + row * 256 + ((c ^ (row & 15)) << 4));
        *(GAS v4u*)(gtile + (size_t)row * ld + 8 * c) = v;
        float m = __builtin_fmaxf(__builtin_fmaxf(__builtin_fabsf(bflo(v.x) * g0.x), __builtin_fabsf(bfhi(v.x) * g0.y)), __builtin_fmaxf(__builtin_fabsf(bflo(v.y) * g0.z), __builtin_fabsf(bfhi(v.y) * g0.w)));
        m = __builtin_fmaxf(m, __builtin_fmaxf(__builtin_fmaxf(__builtin_fabsf(bflo(v.z) * g1.x), __builtin_fabsf(bfhi(v.z) * g1.y)), __builtin_fmaxf(__builtin_fabsf(bflo(v.w) * g1.z), __builtin_fabsf(bfhi(v.w) * g1.w))));
        mx[i] = __builtin_fmaxf(mx[i], m); }
}
DI void attn_head(Frame& F, int hd, int q0, LAS float* scr, const LAS float* gqk, LAS unsigned char* wl, float& ssq, float (&mx)[8]) {
    const int lane = F.lane, r = lane & 31, h = lane >> 5;
    const bf16* qraw = F.QKU; const bf16* kraw = F.QKU + (size_t)T * SBW; const bf16* vT = F.VG;
    LAS unsigned char* kbuf = wl; LAS unsigned char* vbuf = wl + 8192;
    const unsigned koff = (unsigned)((lane >> 4) * (SBW * 2) + 16 * ((lane & 15) ^ (lane >> 4)));
    const unsigned voff = (unsigned)((lane >> 2) * (T * 2) + 16 * ((lane & 3) ^ ((lane >> 4) & 3)));
    const unsigned char* kcol = (const unsigned char*)(kraw + hd * HD); const unsigned char* vrow = (const unsigned char*)(vT + (size_t)(hd * HD) * T);
    bf16x8 qf[8];
    { const bf16* qp = qraw + (size_t)(q0 + r) * SBW + hd * HD + 8 * h;
      v4u raw[8]; float ss = 0.f;
#pragma unroll
      for (int s = 0; s < 8; ++s) raw[s] = *(const GAS v4u*)(qp + 16 * s);
      asm volatile("" ::: "memory");
      attn_dma_k(kcol + (size_t)q0 * (SBW * 2), kbuf, koff); attn_dma_v(vrow + (size_t)q0 * 2, vbuf, voff);
#pragma unroll
      for (int s = 0; s < 8; ++s)
#pragma unroll
          for (int w = 0; w < 4; ++w) ss = dot2bf(raw[s][w], raw[s][w], ss);
      ss = swap_add(ss);
      const float rq = __builtin_amdgcn_rsqf(ss * (1.f / HD) + EPS);
#pragma unroll
      for (int s = 0; s < 8; ++s) { const int d0 = 16 * s + 8 * h;
          const f32x4 a0 = *(const LAS f32x4*)(gqk + d0), a1 = *(const LAS f32x4*)(gqk + d0 + 4);
          qf[s] = pack8(bflo(raw[s][0]) * rq * a0.x, bfhi(raw[s][0]) * rq * a0.y, bflo(raw[s][1]) * rq * a0.z, bfhi(raw[s][1]) * rq * a0.w,
                        bflo(raw[s][2]) * rq * a1.x, bfhi(raw[s][2]) * rq * a1.y, bflo(raw[s][3]) * rq * a1.z, bfhi(raw[s][3]) * rq * a1.w); }
    }
    f32x16 o[4];
#pragma unroll
    for (int db = 0; db < 4; ++db)
#pragma unroll
        for (int i = 0; i < 16; ++i) o[db][i] = 0.f;
    float cdec = 0.f;
    const unsigned kfa = (unsigned)(uintptr_t)kbuf + r * 256 + ((h ^ (r & 15)) << 4);
    unsigned vfa[4];
#pragma unroll
    for (int cc = 0; cc < 4; ++cc) vfa[cc] = (unsigned)(uintptr_t)vbuf + r * 64 + 8 * h + ((cc ^ ((r >> 2) & 3)) << 4);
    for (int kt = q0;; kt -= 32) {
        const bool diag = (kt == q0);
        const int ktn = kt >= 32 ? kt - 32 : 0;
        asm volatile("s_waitcnt vmcnt(8)" ::: "memory");
        v4u kr[8];
        { unsigned ka = kfa; asm volatile("" : "+v"(ka));
#pragma unroll
          for (int s = 0; s < 8; ++s) kr[s] = *(const LAS v4u*)(uintptr_t)(ka ^ (unsigned)(s << 5)); }
        asm volatile("s_waitcnt lgkmcnt(0)" ::: "memory");
        attn_dma_k(kcol + (size_t)ktn * (SBW * 2), kbuf, koff);
        float ks = 0.f;
#pragma unroll
        for (int s = 0; s < 8; ++s)
#pragma unroll
            for (int w = 0; w < 4; ++w) ks = dot2bf(kr[s][w], kr[s][w], ks);
        ks = swap_add(ks);
        const float rkl = __builtin_amdgcn_rsqf(ks * (1.f / HD) + EPS);
        f32x16 st;
#pragma unroll
        for (int i = 0; i < 16; ++i) st[i] = 0.f;
#pragma unroll
        for (int s = 0; s < 8; ++s) st = MFMA32(__builtin_bit_cast(bf16x8, kr[s]), qf[s], st);
        if (h == 0) scr[r] = rkl;
        f32x4 rk4[4];
#pragma unroll
        for (int m = 0; m < 4; ++m) rk4[m] = *(const LAS f32x4*)(scr + 8 * m + 4 * h);
        float z[16], sp[16];
#pragma unroll
        for (int i = 0; i < 16; ++i) { z[i] = st[i] * rk4[i >> 2][i & 3]; const float e = __builtin_amdgcn_exp2f(-__builtin_fabsf(z[i])); sp[i] = __builtin_fmaxf(z[i], 0.f) + __builtin_amdgcn_logf(1.0f + e); }
        if (diag) {
#pragma unroll
            for (int i = 0; i < 16; ++i) if (!(crow(i, h) < r)) sp[i] = 0.f; }
        float G[8];
#pragma unroll
        for (int m = 0; m < 4; ++m) { const float sm = (sp[4 * m] + sp[4 * m + 1]) + (sp[4 * m + 2] + sp[4 * m + 3]);
            auto rr = __builtin_amdgcn_permlane32_swap(__float_as_uint(sm), __float_as_uint(sm), false, false); G[2 * m] = __uint_as_float(rr[0]); G[2 * m + 1] = __uint_as_float(rr[1]); }
        float Tg[8]; Tg[7] = 0.f;
#pragma unroll
        for (int g = 6; g >= 0; --g) Tg[g] = Tg[g + 1] + G[g + 1];
        const float total = Tg[0] + G[0];
        float a[16];
#pragma unroll
        for (int m = 0; m < 4; ++m) { const float s3 = cdec + (h ? Tg[2 * m + 1] : Tg[2 * m]); const float s2 = s3 + sp[4 * m + 3], s1 = s2 + sp[4 * m + 2], s0 = s1 + sp[4 * m + 1];
            a[4 * m + 3] = __builtin_amdgcn_exp2f(z[4 * m + 3] - sp[4 * m + 3] - s3); a[4 * m + 2] = __builtin_amdgcn_exp2f(z[4 * m + 2] - sp[4 * m + 2] - s2);
            a[4 * m + 1] = __builtin_amdgcn_exp2f(z[4 * m + 1] - sp[4 * m + 1] - s1); a[4 * m] = __builtin_amdgcn_exp2f(z[4 * m] - sp[4 * m] - s0); }
        if (diag) {
#pragma unroll
            for (int i = 0; i < 16; ++i) if (!(crow(i, h) < r)) a[i] = 0.f; }
        cdec += total;
        const bf16x8 af0 = pack8(a[0], a[1], a[2], a[3], a[4], a[5], a[6], a[7]), af1 = pack8(a[8], a[9], a[10], a[11], a[12], a[13], a[14], a[15]);
        asm volatile("s_waitcnt vmcnt(8)" ::: "memory");
        v2u vlo[4][2], vhi[4][2];
#pragma unroll
        for (int db = 0; db < 4; ++db)
#pragma unroll
            for (int s2 = 0; s2 < 2; ++s2) { vlo[db][s2] = *(const LAS v2u*)(uintptr_t)(vfa[2 * s2] + db * 2048); vhi[db][s2] = *(const LAS v2u*)(uintptr_t)(vfa[2 * s2 + 1] + db * 2048); }
        asm volatile("s_waitcnt lgkmcnt(0)" ::: "memory");
        attn_dma_v(vrow + (size_t)ktn * 2, vbuf, voff);
#pragma unroll
        for (int db = 0; db < 4; ++db) {
            v4u v0; v0.x = vlo[db][0].x; v0.y = vlo[db][0].y; v0.z = vhi[db][0].x; v0.w = vhi[db][0].y;
            v4u v1; v1.x = vlo[db][1].x; v1.y = vlo[db][1].y; v1.z = vhi[db][1].x; v1.w = vhi[db][1].y;
            o[db] = MFMA32(__builtin_bit_cast(bf16x8, v0), af0, o[db]); o[db] = MFMA32(__builtin_bit_cast(bf16x8, v1), af1, o[db]); }
        if (kt == 0 || __all(cdec > ATT_EXIT)) break;
    }
    asm volatile("s_waitcnt vmcnt(0)" ::: "memory");
    float ss = 0.f;
#pragma unroll
    for (int db = 0; db < 4; ++db)
#pragma unroll
        for (int i = 0; i < 16; ++i) ss += o[db][i] * o[db][i];
    ssq += swap_add(ss);
#pragma unroll
    for (int db = 0; db < 4; ++db)
#pragma unroll
        for (int m = 0; m < 4; ++m) { v2u p; p.x = pk2(o[db][4 * m], o[db][4 * m + 1]); p.y = pk2(o[db][4 * m + 2], o[db][4 * m + 3]); stash_put(kbuf, r, h, db, m, p); }
    stash_store(kbuf, F.MIX + (size_t)q0 * DM + hd * HD, DM, lane, F.sb_og + hd * HD, mx);
}
DI void sgu_group(Frame& F, int g, int n, int rq, LAS float* scr, LAS unsigned char* wl, float& ssq, float (&mx)[8]) {
    const int lane = F.lane, r = lane & 31, h = lane >> 5;
    const bf16* gvT = F.VG + (size_t)SBW * T;
    const bf16* ub = F.QKU + (size_t)2 * T * SBW;
    const int tl = 32 * rq + r;
    const int nks = 2 * (rq + 1);
    unsigned goff = (unsigned)((lane >> 4) * (T * 2) + 16 * ((lane & 15) ^ (lane >> 4)));
    const unsigned char* gtile = (const unsigned char*)(gvT + (size_t)(g * 128) * T + 128 * n);
    auto dma_half = [&](int half) {
        asm volatile("" : "+v"(goff));
#pragma unroll
        for (int i = 0; i < 16; ++i)
            __builtin_amdgcn_global_load_lds((const unsigned*)(gtile + (size_t)(half * 64 + 4 * i) * (T * 2) + (goff ^ (64u * (i & 3)))), (LAS unsigned*)(wl + i * 1024), 16, 0, 0); };
    float gp[2][2];
#pragma unroll
    for (int i = 0; i < 2; ++i) { const int s = lane + 64 * i; gp[i][0] = F.GVP[(size_t)g * T + 128 * n + s]; gp[i][1] = F.GVP[(size_t)(16 + g) * T + 128 * n + s]; }
    const float* wrow = F.sgu_w + ((size_t)g * 128 + tl) * 128 + 8 * h;
    f32x4 w0[8], w1[8];
#pragma unroll
    for (int ks = 0; ks < 8; ++ks) if (ks < nks) { w0[ks] = *(const f32x4*)(wrow + 16 * ks); w1[ks] = *(const f32x4*)(wrow + 16 * ks + 4); }
    asm volatile("" ::: "memory");
    dma_half(0);
#pragma unroll
    for (int i = 0; i < 2; ++i) scr[lane + 64 * i] = __builtin_amdgcn_rsqf((gp[i][0] + gp[i][1]) * (1.f / 128.f) + EPS);
    bf16x8 wf[8];
    {
#pragma unroll
      for (int ks = 0; ks < 8; ++ks) if (ks < nks) {
          const f32x4 r0 = *(const LAS f32x4*)(scr + 16 * ks + 8 * h), r1 = *(const LAS f32x4*)(scr + 16 * ks + 8 * h + 4);
          const int s0 = 16 * ks + 8 * h;
          float wv[8] = {w0[ks].x * r0.x, w0[ks].y * r0.y, w0[ks].z * r0.z, w0[ks].w * r0.w, w1[ks].x * r1.x, w1[ks].y * r1.y, w1[ks].z * r1.z, w1[ks].w * r1.w};
#pragma unroll
          for (int j = 0; j < 8; ++j) if (s0 + j > tl) wv[j] = 0.f;
          wf[ks] = pack8(wv[0], wv[1], wv[2], wv[3], wv[4], wv[5], wv[6], wv[7]); } }
    f32x16 d[4];
#pragma unroll
    for (int cb = 0; cb < 4; ++cb)
#pragma unroll
        for (int i = 0; i < 16; ++i) d[cb][i] = 0.f;
#pragma unroll
    for (int half = 0; half < 2; ++half) {
        asm volatile("s_waitcnt vmcnt(0)" ::: "memory");
#pragma unroll
        for (int cbl = 0; cbl < 2; ++cbl) { unsigned aa = (unsigned)(uintptr_t)wl + (cbl * 32 + r) * 256 + ((h ^ (r & 15)) << 4); asm volatile("" : "+v"(aa));
#pragma unroll
            for (int ks = 0; ks < 8; ++ks) if (ks < nks) { const v4u av = *(const LAS v4u*)(uintptr_t)(aa ^ (unsigned)(ks << 5));
                d[2 * half + cbl] = MFMA32(__builtin_bit_cast(bf16x8, av), wf[ks], d[2 * half + cbl]); } }
        if (half == 0) { asm volatile("s_waitcnt lgkmcnt(0)" ::: "memory"); dma_half(1); }
    }
    const float bias = F.sgu_b[g * 128 + tl];
    f32x4 gg[4][4];
#pragma unroll
    for (int cb = 0; cb < 4; ++cb)
#pragma unroll
        for (int m = 0; m < 4; ++m) gg[cb][m] = *(const f32x4*)(F.sgu_vg + g * 128 + cb * 32 + 8 * m + 4 * h);
    asm volatile("s_waitcnt vmcnt(0) lgkmcnt(0)" ::: "memory");
    { const unsigned uoff = (unsigned)((lane >> 4) * (SBW * 2) + 16 * ((lane & 15) ^ (lane >> 4)));
      attn_dma_k((const unsigned char*)(ub + (size_t)(128 * n + 32 * rq) * SBW + g * 128), wl, uoff); }
    asm volatile("s_waitcnt vmcnt(0)" ::: "memory");
    LAS unsigned char* st = wl + 8192;
    float ss = 0.f;
#pragma unroll
    for (int cb = 0; cb < 4; ++cb)
#pragma unroll
        for (int m = 0; m < 4; ++m) {
            const v2u uu = *(const LAS v2u*)(wl + r * 256 + (((4 * cb + m) ^ (r & 15)) << 4) + 8 * h);
            const float o0 = bflo(uu.x) * (d[cb][4 * m] * gg[cb][m].x + bias), o1 = bfhi(uu.x) * (d[cb][4 * m + 1] * gg[cb][m].y + bias), o2 = bflo(uu.y) * (d[cb][4 * m + 2] * gg[cb][m].z + bias), o3 = bfhi(uu.y) * (d[cb][4 * m + 3] * gg[cb][m].w + bias);
            ss += (o0 * o0 + o1 * o1) + (o2 * o2 + o3 * o3);
            v2u p; p.x = pk2(o0, o1); p.y = pk2(o2, o3); stash_put(st, r, h, cb, m, p); }
    ssq += swap_add(ss);
    stash_store(st, F.MIX + (size_t)(128 * n + 32 * rq) * DM + SBW + g * 128, DM, lane, F.sgu_og + g * 128, mx);
}
DI float row_fmax(float v) { v = __builtin_fmaxf(v, dpp_f2<0xB1>(v)); v = __builtin_fmaxf(v, dpp_f2<0x4E>(v)); v = __builtin_fmaxf(v, dpp_f2<0x124>(v)); v = __builtin_fmaxf(v, dpp_f2<0x128>(v)); return v; }
DI void renorm_q8(Frame& F, int q0, const LAS float* fA, const LAS float* fS, int w, int lane) {
    const int c = lane & 15, rl = lane >> 4;
    float fa[8], fs[8];
#pragma unroll
    for (int i = 0; i < 8; ++i) { fa[i] = fA[4 * i + rl]; fs[i] = fS[4 * i + rl]; }
#pragma unroll 1
    for (int tt = 0; tt < 4; ++tt) { const int colt = (tt < 2 ? 0 : SBW) + (2 * w + (tt & 1)) * 128; const float* gn = (tt < 2 ? F.sb_og : F.sgu_og) + (2 * w + (tt & 1)) * 128;
        const f32x4 g0 = *(const f32x4*)(gn + 8 * c), g1 = *(const f32x4*)(gn + 8 * c + 4); v4u q[8];
#pragma unroll
        for (int i = 0; i < 8; ++i) q[i] = *(const GAS v4u*)(F.MIX + (size_t)(q0 + 4 * i + rl) * DM + colt + 8 * c);
#pragma unroll
        for (int i = 0; i < 8; ++i) { const v4u v = q[i]; const float f = tt < 2 ? fa[i] : fs[i];
            const int a0 = (int)__builtin_rintf(bflo(v.x) * g0.x * f), a1 = (int)__builtin_rintf(bfhi(v.x) * g0.y * f), a2 = (int)__builtin_rintf(bflo(v.y) * g0.z * f), a3 = (int)__builtin_rintf(bfhi(v.y) * g0.w * f);
            const int a4 = (int)__builtin_rintf(bflo(v.z) * g1.x * f), a5 = (int)__builtin_rintf(bfhi(v.z) * g1.y * f), a6 = (int)__builtin_rintf(bflo(v.w) * g1.z * f), a7 = (int)__builtin_rintf(bfhi(v.w) * g1.w * f);
            v2u p; p.x = (unsigned)(a0 & 255) | ((unsigned)(a1 & 255) << 8) | ((unsigned)(a2 & 255) << 16) | ((unsigned)(a3 & 255) << 24);
            p.y = (unsigned)(a4 & 255) | ((unsigned)(a5 & 255) << 8) | ((unsigned)(a6 & 255) << 16) | ((unsigned)(a7 & 255) << 24);
            *(GAS v2u*)(F.MIXQ + (size_t)(q0 + 4 * i + rl) * DM + colt + 8 * c) = p; } }
}
DI void p2_mixers(Frame& F) {
    LAS unsigned char* wl = F.lds + F.wave * 16384;
    LAS float* scr = (LAS float*)(F.lds + RING_BYTES) + F.wave * 128;
    LAS float* xch = (LAS float*)(F.lds + RING_BYTES + 4096);
    LAS float* gqk = (LAS float*)(F.lds + RING_BYTES + 8192);
    if (F.tid < HD) gqk[F.tid] = F.q_g[F.tid] * F.k_g[F.tid] * QSCALE;
    __syncthreads();
    const int lane = F.lane, r = lane & 31, h = lane >> 5, w = F.wave;
    for (int unit = F.vcu; unit < T / 32; unit += F.G) {
        asm volatile("" : "+v"(F.lane));
        const int q0 = 32 * unit, n = unit >> 2, rq = unit & 3;
        float ssa = 0.f, sss = 0.f; float mxa[8], mxs[8];
#pragma unroll
        for (int i = 0; i < 8; ++i) { mxa[i] = 0.f; mxs[i] = 0.f; }
#pragma unroll 1
        for (int hh = 0; hh < 2; ++hh) attn_head(F, 2 * w + hh, q0, scr, gqk, wl, ssa, mxa);
#pragma unroll 1
        for (int hh = 0; hh < 2; ++hh) sgu_group(F, 2 * w + hh, n, rq, scr, wl, sss, mxs);
        if (h == 0) { xch[w * 32 + r] = ssa; xch[256 + w * 32 + r] = sss; }
#pragma unroll
        for (int i = 0; i < 8; ++i) { const float a = row_fmax(mxa[i]), b = row_fmax(mxs[i]); if ((lane & 15) == 0) { xch[512 + w * 32 + 4 * i + (lane >> 4)] = a; xch[768 + w * 32 + 4 * i + (lane >> 4)] = b; } }
        VM_WAIT();
        __syncthreads();
        float ta = 0.f, ts = 0.f, ma = 0.f, ms = 0.f;
#pragma unroll
        for (int ww = 0; ww < 8; ++ww) { ta += xch[ww * 32 + r]; ts += xch[256 + ww * 32 + r]; ma = __builtin_fmaxf(ma, xch[512 + ww * 32 + r]); ms = __builtin_fmaxf(ms, xch[768 + ww * 32 + r]); }
        const float rsa = __builtin_amdgcn_rsqf(ta * (1.f / SBW) + EPS), rss = __builtin_amdgcn_rsqf(ts * (1.f / SBW) + EPS);
        const float rowmax = __builtin_fmaxf(rsa * ma, rss * ms), inv = rowmax > 0.f ? 127.0f / rowmax : 0.f;
        if (h == 0) { scr[r] = rsa * inv; scr[32 + r] = rss * inv; if (w == 0) F.SA2[q0 + r] = rowmax * (1.0f / 127.0f); }
        renorm_q8(F, q0, scr, scr + 32, w, lane);
        __syncthreads();
    }
}

DI unsigned f_ord(float f) { const unsigned u = __float_as_uint(f); return (u & 0x80000000u) ? ~u : (u | 0x80000000u); }
DI float ord_f(unsigned k) { return __uint_as_float((k & 0x80000000u) ? (k ^ 0x80000000u) : ~k); }
DI unsigned bperm(unsigned v, int src_lane) { return (unsigned)__builtin_amdgcn_ds_bpermute(src_lane << 2, (int)v); }

constexpr int P5_D = 8;
constexpr int P5_SLOT = 1024;
constexpr int P5_USL = P5_D * P5_SLOT;
constexpr int P5_PART = P5_USL + 2048;
constexpr int P5_VSL = P5_PART + 2048;
constexpr int P5_WAVE = 19456;
DI void p5_dma_half(const unsigned char* rowp, int hoff, LAS unsigned char* slot, int lane) {
    __builtin_amdgcn_global_load_lds((const unsigned*)(rowp + hoff + (size_t)(16u * (unsigned)lane)), (LAS unsigned*)(slot), 16, 0, 0);
}
template<int IOFF> DI void p5_dma_half_io(const unsigned char* rowp, int hoff, LAS unsigned char* slot0, int lane) {
    __builtin_amdgcn_global_load_lds((const unsigned*)(rowp + hoff - IOFF + (size_t)(16u * (unsigned)lane)), (LAS unsigned*)(slot0), 16, IOFF, 0);
}
static_assert(TROW == 2048, "ent_off");
DI unsigned ent_off(unsigned e) { return (e >> 16) << 11; }
DI int tr_reduce16(const int (&p)[16], int lane) {
    const bool b0 = lane & 1, b1 = lane & 2, b2 = lane & 4, b3 = lane & 8;
    int a[8], q[4], c[2];
#pragma unroll
    for (int i = 0; i < 8; ++i) { const int keep = b0 ? p[2 * i + 1] : p[2 * i], send = b0 ? p[2 * i] : p[2 * i + 1]; a[i] = keep + (int)dpp_u<0xB1>((unsigned)send); }
#pragma unroll
    for (int i = 0; i < 4; ++i) { const int keep = b1 ? a[2 * i + 1] : a[2 * i], send = b1 ? a[2 * i] : a[2 * i + 1]; q[i] = keep + (int)dpp_u<0x4E>((unsigned)send); }
#pragma unroll
    for (int i = 0; i < 2; ++i) { const int keep = b2 ? q[2 * i + 1] : q[2 * i], send = b2 ? q[2 * i] : q[2 * i + 1]; c[i] = keep + __builtin_amdgcn_ds_swizzle(send, 0x101F); }
    int d; { const int keep = b3 ? c[1] : c[0], send = b3 ? c[0] : c[1]; d = keep + __builtin_amdgcn_ds_swizzle(send, 0x201F); }
    d += __builtin_amdgcn_ds_swizzle(d, 0x401F);
    const auto rr = __builtin_amdgcn_permlane32_swap((unsigned)d, (unsigned)d, false, false); return (int)(rr[0] + rr[1]);
}
DI void p5_peer(Frame& F, const XcdBarrier& bar) {
    static_assert(P5_D == 8 && P5_VSL + 2048 <= 17408 && P5_WAVE * NWAVES <= LDSCTL_OFF, "P5 LDS map");
    const int lane = F.lane, gw = F.vcu * NWAVES + F.wave, NGW = F.G * NWAVES;
    LAS unsigned char* ring = F.lds + F.wave * P5_WAVE;
    LAS float* part = (LAS float*)(ring + P5_PART);
    LAS float* usl = (LAS float*)(ring + P5_USL); LAS float* vsl = (LAS float*)(ring + P5_VSL);
    LAS unsigned* ent = (LAS unsigned*)(ring + 17408);
    LAS unsigned* hst = (LAS unsigned*)ring;
    LAS int* tids = (LAS int*)(ring + 16384); LAS float* tgc = (LAS float*)(ring + 16384 + 512);
    LAS float* ascl = (LAS float*)(F.lds + LDSCTL_OFF + 2048 + F.wave * 16);
    int pa, pb;
    { const int l = lane;
      if (l < 16) { pa = 0; pb = l; } else if (l < 24) { pa = 1; pb = l - 16; } else if (l < 29) { pa = 2; pb = l - 24; } else if (l < 33) { pa = 3; pb = l - 29; }
      else if (l < 36) { pa = 4; pb = l - 33; } else if (l < 38) { pa = 5; pb = l - 36; } else if (l < 40) { pa = 6; pb = l - 38; } else if (l < 42) { pa = 7; pb = l - 40; }
      else if (l < 50) { pa = l - 34; pb = 0; } else { pa = 0; pb = 0; } }
    const unsigned pab = (unsigned)(pa << 4 | pb);
    for (int g = gw; g < T / 4; g += NGW) {
        const bool first = (g == gw);
        v2u gpk[16]; f32x4 hs4;
        { int lane = F.lane; asm volatile("" : "+v"(lane));
          hs4 = *(const GAS f32x4*)(F.HSS + (size_t)lane * T + 4 * g);
#pragma unroll
          for (int jj = 0; jj < 16; ++jj) { const f32x4 gn = ((const GAS f32x4*)F.ffn_g)[lane + 64 * jj]; gpk[jj].x = pk2(gn.x, gn.y); gpk[jj].y = pk2(gn.z, gn.w); } }
#pragma unroll 1
        for (int tok = 0; tok < 4; ++tok) {
            int lane = F.lane; asm volatile("" : "+v"(lane));
            const int t = 4 * g + tok;
            const float rstd = __builtin_amdgcn_rsqf(wave_fsum_u(tok == 0 ? hs4.x : tok == 1 ? hs4.y : tok == 2 ? hs4.z : hs4.w) * (1.f / DM) + EPS);
            { const GAS v2u* hp = (const GAS v2u*)(F.HB + (size_t)t * DM) + lane; float hv[64]; float m = 0.f;
#pragma unroll
              for (int jj = 0; jj < 16; ++jj) { const v2u q = hp[64 * jj]; const v2u gq = gpk[jj];
                  hv[4 * jj] = bflo(q.x) * bflo(gq.x); hv[4 * jj + 1] = bfhi(q.x) * bfhi(gq.x); hv[4 * jj + 2] = bflo(q.y) * bflo(gq.y); hv[4 * jj + 3] = bfhi(q.y) * bfhi(gq.y);
                  m = __builtin_fmaxf(__builtin_fmaxf(m, __builtin_fmaxf(__builtin_fabsf(hv[4 * jj]), __builtin_fabsf(hv[4 * jj + 1]))), __builtin_fmaxf(__builtin_fabsf(hv[4 * jj + 2]), __builtin_fabsf(hv[4 * jj + 3]))); }
              m = wave_fmax_u(m);
              const float inv = m > 0.f ? 119.0f / m : 0.f; unsigned wh[8], wl[8];
              constexpr float HMAGIC = 12582912.0f + 136.0f; constexpr unsigned HK = 0x4B400000u * 0x01010101u;
#pragma unroll
              for (int j = 0; j < 8; ++j) { unsigned t0 = 0u, t1 = 0u;
#pragma unroll
                  for (int n = 0; n < 4; ++n) { t0 += __float_as_uint(__builtin_fmaf(hv[8 * j + n], inv, HMAGIC)) << (8 * n); t1 += __float_as_uint(__builtin_fmaf(hv[8 * j + 4 + n], inv, HMAGIC)) << (8 * n); }
                  t0 -= HK; t1 -= HK;
                  wl[j] = ((t0 & 0x0F0F0F0Fu) | ((t1 & 0x0F0F0F0Fu) << 4)) ^ 0x88888888u;
                  wh[j] = (((t0 >> 4) & 0x0F0F0F0Fu) | (t1 & 0xF0F0F0F0u)) ^ 0x88888888u; }
              LAS v4u* hw = (LAS v4u*)(hst + (tok * 64 + lane) * 16);
              v4u o; o.x = wh[0]; o.y = wh[1]; o.z = wh[2]; o.w = wh[3]; hw[0] = o; o.x = wh[4]; o.y = wh[5]; o.z = wh[6]; o.w = wh[7]; hw[1] = o;
              o.x = wl[0]; o.y = wl[1]; o.z = wl[2]; o.w = wl[3]; hw[2] = o; o.x = wl[4]; o.y = wl[5]; o.z = wl[6]; o.w = wl[7]; hw[3] = o;
              if (lane == 0) ascl[tok] = rstd * m * (1.0f / 119.0f); }
            const float* scrow = F.SC + (size_t)t * NSC;
            for (int hd = 0; hd < PH; hd += 2) {
                const int qrow_ = gw + (tok * 4 + (hd >> 1)) * NGW; const int qrow = (first && qrow_ < 2 * NEXP) ? qrow_ : gw;
                const int rho = lane >> 4, i16 = lane & 15;
                const float* sp = scrow + (hd + (rho >> 1)) * 256 + (rho & 1) * 128 + 8 * i16;
                const f32x4 sva = *(const GAS f32x4*)sp, svb = *(const GAS f32x4*)(sp + 4);
                asm volatile("" ::: "memory");
                f32x4 qv[16];
                tq_load(F, qrow, lane, qv);
                unsigned sk[8], res = 0u;
                { const unsigned idx0 = (unsigned)(8 * i16); const float sv8[8] = {sva.x, sva.y, sva.z, sva.w, svb.x, svb.y, svb.z, svb.w};
#pragma unroll
                  for (int e = 0; e < 8; ++e) sk[e] = (f_ord(sv8[e]) & ~0x7Fu) | (idx0 + e);
                  constexpr int NET[19][2] = {{0,1},{2,3},{4,5},{6,7},{0,2},{1,3},{4,6},{5,7},{1,2},{5,6},{0,4},{1,5},{2,6},{3,7},{2,4},{3,5},{1,2},{3,4},{5,6}};
#pragma unroll
                  for (int c = 0; c < 19; ++c) { const unsigned hi = umax(sk[NET[c][0]], sk[NET[c][1]]), lo = umin(sk[NET[c][0]], sk[NET[c][1]]); sk[NET[c][0]] = hi; sk[NET[c][1]] = lo; } }
#pragma unroll
                for (int rnd = 0; rnd < PK; ++rnd) {
                    const unsigned mm = row_umax(sk[0]);
                    const bool win = (sk[0] == mm);
#pragma unroll
                    for (int e = 0; e < 7; ++e) sk[e] = win ? sk[e + 1] : sk[e];
                    sk[7] = win ? 0u : sk[7];
                    res = (i16 == rnd) ? mm : res;
                }
                unsigned ck[2], res2[2];
#pragma unroll
                for (int h = 0; h < 2; ++h) { const unsigned ka = bperm(res, 32 * h + pa), kb = bperm(res, 32 * h + 16 + pb);
                    const float cv = ord_f(ka & ~0x7Fu) + ord_f(kb & ~0x7Fu);
                    ck[h] = (lane < 50) ? ((f_ord(cv) & ~0x3Fu) | (unsigned)lane) : 0u; res2[h] = 0u; }
                { unsigned rk[2] = {0u, 0u};
#pragma unroll
                  for (int c = 0; c < 50; ++c) {
#pragma unroll
                      for (int h = 0; h < 2; ++h) { const unsigned sk = (unsigned)__builtin_amdgcn_readlane((int)ck[h], c); rk[h] += (sk > ck[h]) ? 1u : 0u; } }
#pragma unroll
                  for (int h = 0; h < 2; ++h) { const unsigned dst = (lane < 50) ? rk[h] : (unsigned)lane; res2[h] = (unsigned)__builtin_amdgcn_ds_permute((int)(dst << 2), (int)ck[h]); } }
#pragma unroll
                for (int h = 0; h < 2; ++h) {
                    const unsigned pid = res2[h] & 0x3Fu; const unsigned ab = bperm(pab, (int)pid);
                    const unsigned i1 = bperm(res, 32 * h + (int)(ab >> 4)) & 0x7Fu, i2 = bperm(res, 32 * h + 16 + (int)(ab & 15u)) & 0x7Fu;
                    const int expert = (int)(i1 * PNK + i2);
                    const float best = ord_f(res2[h] & ~0x3Fu) * rstd;
                    const float bmax = __uint_as_float((unsigned)__builtin_amdgcn_readlane((int)__float_as_uint(best), 0));
                    const float ex = (lane < 16) ? __builtin_amdgcn_exp2f((best - bmax) * 1.4426950408889634f) : 0.f;
                    const float gate = (lane < 16) ? ex * __builtin_amdgcn_rcpf(row_fsum(ex)) : 0.f;
                    if (lane < 16) { tids[(hd + h) * 16 + lane] = expert; tgc[(hd + h) * 16 + lane] = gate; }
                }
                tq_store(F, qrow, lane, qv);
            }
            { const int e0 = tids[lane], e1 = tids[64 + lane]; const float g0 = tgc[lane], g1 = tgc[64 + lane];
              LAS unsigned* cnt = (LAS unsigned*)tids; LAS unsigned* pre = (LAS unsigned*)tgc;
              cnt[lane] = 0u; cnt[64 + lane] = 0u;
              const int b0 = e0 >> 7, b1 = e1 >> 7;
              const unsigned p0 = __hip_atomic_fetch_add(cnt + b0, 1u, __ATOMIC_RELAXED, __HIP_MEMORY_SCOPE_WORKGROUP), p1 = __hip_atomic_fetch_add(cnt + b1, 1u, __ATOMIC_RELAXED, __HIP_MEMORY_SCOPE_WORKGROUP);
              const unsigned c0 = cnt[lane], c1 = cnt[64 + lane];
              unsigned x0 = c0, x1 = c1;
              x0 += dpp_u<0x111>(x0); x1 += dpp_u<0x111>(x1); x0 += dpp_u<0x112>(x0); x1 += dpp_u<0x112>(x1); x0 += dpp_u<0x114>(x0); x1 += dpp_u<0x114>(x1); x0 += dpp_u<0x118>(x0); x1 += dpp_u<0x118>(x1);
              const unsigned a0 = (unsigned)__builtin_amdgcn_readlane((int)x0, 15), a1 = (unsigned)__builtin_amdgcn_readlane((int)x0, 31), a2 = (unsigned)__builtin_amdgcn_readlane((int)x0, 47), a3 = (unsigned)__builtin_amdgcn_readlane((int)x0, 63);
              const unsigned d0 = (unsigned)__builtin_amdgcn_readlane((int)x1, 15), d1 = (unsigned)__builtin_amdgcn_readlane((int)x1, 31), d2 = (unsigned)__builtin_amdgcn_readlane((int)x1, 47);
              const unsigned tot0 = a0 + a1 + a2 + a3;
              const unsigned o0 = (lane >= 16 ? a0 : 0u) + (lane >= 32 ? a1 : 0u) + (lane >= 48 ? a2 : 0u), o1 = tot0 + (lane >= 16 ? d0 : 0u) + (lane >= 32 ? d1 : 0u) + (lane >= 48 ? d2 : 0u);
              pre[lane] = x0 + o0 - c0; pre[64 + lane] = x1 + o1 - c1;
              const unsigned s0 = pre[b0] + p0, s1 = pre[b1] + p1;
              ent[tok * 128 + s0] = ((unsigned)e0 << 16) | f2bf(g0); ent[tok * 128 + s1] = ((unsigned)e1 << 16) | f2bf(g1); }
        }
        int lane = F.lane; asm volatile("" : "+v"(lane));
        if (first) {
            for (int qrow = gw + 16 * NGW; qrow < 2 * NEXP; qrow += NGW) { f32x4 qv[16]; tq_load(F, qrow, lane, qv); tq_store(F, qrow, lane, qv); }
            xcd_barrier(bar);
        }
        asm volatile("s_waitcnt vmcnt(0) lgkmcnt(0)" ::: "memory");
        int Hh[4][8], Hl[4][8]; float asc[4];
#pragma unroll
        for (int tok = 0; tok < 4; ++tok) { const LAS v4u* p = (const LAS v4u*)(hst + (tok * 64 + lane) * 16); const v4u a = p[0], b = p[1], c = p[2], d = p[3];
            Hh[tok][0] = (int)a.x; Hh[tok][1] = (int)a.y; Hh[tok][2] = (int)a.z; Hh[tok][3] = (int)a.w; Hh[tok][4] = (int)b.x; Hh[tok][5] = (int)b.y; Hh[tok][6] = (int)b.z; Hh[tok][7] = (int)b.w;
            Hl[tok][0] = (int)c.x; Hl[tok][1] = (int)c.y; Hl[tok][2] = (int)c.z; Hl[tok][3] = (int)c.w; Hl[tok][4] = (int)d.x; Hl[tok][5] = (int)d.y; Hl[tok][6] = (int)d.z; Hl[tok][7] = (int)d.w;
            asc[tok] = ascl[tok]; }
        const unsigned vfirst = ent_off(ent[((lane >> 2) & 1) * 128 + (lane & 3)]);
        const unsigned fe = ent_off(ent[(lane & 3) * 128 + ((lane >> 2) & 1)]);
        asm volatile("s_waitcnt lgkmcnt(0)" ::: "memory");
#pragma unroll
        for (int tok = 0; tok < 4; ++tok) { const unsigned e0 = ent[tok * 128 + lane] >> 16, e1 = ent[tok * 128 + 64 + lane] >> 16;
            usl[tok * 128 + lane] = F.USC[e0]; usl[tok * 128 + 64 + lane] = F.USC[e1]; vsl[tok * 128 + lane] = F.VSC[e0]; vsl[tok * 128 + 64 + lane] = F.VSC[e1]; }
        asm volatile("s_waitcnt vmcnt(0)" ::: "memory");
#pragma unroll
        for (int r = 0; r < P5_D; ++r) p5_dma_half(F.UT + (size_t)(unsigned)__builtin_amdgcn_readlane((int)fe, r), 0, ring + r * P5_SLOT, lane);
        v4u cu[4];
        asm volatile("s_waitcnt vmcnt(4)" ::: "memory");
#pragma unroll
        for (int tok = 0; tok < 4; ++tok) cu[tok] = ((const LAS v4u*)(ring + tok * P5_SLOT))[lane];
#pragma unroll
        for (int uh = 0; uh < 2; ++uh) {
            for (int b = 0; b < 8; ++b) {
                int lane = F.lane; asm volatile("" : "+v"(lane));
                unsigned nentv[4];
#pragma unroll
                for (int tok = 0; tok < 4; ++tok) { const int n = 16 * b + 2 + (lane & 15); nentv[tok] = ent_off(ent[tok * 128 + (n < 128 ? n : 127)]); }
                int P[4][16];
#pragma unroll
                for (int kk = 0; kk < 16; kk += 2) {
#pragma unroll
                    for (int k2 = 0; k2 < 2; ++k2) {
                        const int k = kk + k2;
                        const bool wrap = (b == 7 && kk == 14);
                        asm volatile("s_waitcnt lgkmcnt(0)" ::: "memory");
#pragma unroll
                        for (int tok = 0; tok < 4; ++tok) asm volatile("" : "+v"(cu[tok].x), "+v"(cu[tok].y), "+v"(cu[tok].z), "+v"(cu[tok].w));
#pragma unroll
                        for (int tok = 0; tok < 4; ++tok) {
                            unsigned ne = (unsigned)__builtin_amdgcn_readlane((int)nentv[tok], k); const unsigned char* base = F.UT; int hoff = 1024 * uh;
                            if (wrap) {
                                if (uh == 0) { ne = (unsigned)__builtin_amdgcn_readlane((int)fe, 4 * k2 + tok); hoff = 1024; }
                                else { ne = (unsigned)__builtin_amdgcn_readlane((int)vfirst, 4 * k2 + tok); base = F.VT; hoff = 0; } }
                            p5_dma_half(base + (size_t)ne, hoff, ring + (4 * k2 + tok) * P5_SLOT, lane); }
                        asm volatile("s_waitcnt vmcnt(4)" ::: "memory");
                        v4u nx4[4];
#pragma unroll
                        for (int tok = 0; tok < 4; ++tok) nx4[tok] = ((const LAS v4u*)(ring + (4 * (k2 ^ 1) + tok) * P5_SLOT))[lane];
                        unsigned uw[4][4];
#pragma unroll
                        for (int tok = 0; tok < 4; ++tok) { uw[tok][0] = cu[tok].x; uw[tok][1] = cu[tok].y; uw[tok][2] = cu[tok].z; uw[tok][3] = cu[tok].w;
                            asm volatile("" : "+v"(uw[tok][0]), "+v"(uw[tok][1]), "+v"(uw[tok][2]), "+v"(uw[tok][3])); }
                        int is0[4] = {0, 0, 0, 0}, is1[4] = {0, 0, 0, 0};
#pragma unroll
                        for (int jj = 0; jj < 4; ++jj) {
#pragma unroll
                            for (int tok = 0; tok < 4; ++tok) { is0[tok] = __builtin_amdgcn_sdot8(Hh[tok][4 * uh + jj], (int)uw[tok][jj], is0[tok], false); is1[tok] = __builtin_amdgcn_sdot8(Hl[tok][4 * uh + jj], (int)uw[tok][jj], is1[tok], false); } }
#pragma unroll
                        for (int tok = 0; tok < 4; ++tok) { int pv = 16 * is0[tok] + is1[tok];
                            asm volatile("" : "+v"(pv));
                            P[tok][k] = pv; cu[tok] = nx4[tok]; }
                    }
                }
#pragma unroll
                for (int tok = 0; tok < 4; ++tok) { const int tot = tr_reduce16(P[tok], lane);
                    if (lane < 16) { const int ei = tok * 128 + 16 * b + lane; LAS int* parti = (LAS int*)part;
                        if (uh == 0) parti[ei] = tot;
                        else { const unsigned e = ent[ei]; ent[ei] = (e & 0xffff0000u) | f2bf(__uint_as_float(e << 16) * pg8::gelu_tanh((float)(parti[ei] + tot) * usl[ei] * asc[tok])); } } }
            }
        }
        float Q[4]; int csum[4]; LAS unsigned* cql = (LAS unsigned*)usl;
#pragma unroll
        for (int tok = 0; tok < 4; ++tok) { const int i0 = tok * 128 + lane, i1 = i0 + 64; const unsigned e0 = ent[i0], e1 = ent[i1];
            const float c0 = __uint_as_float(f2bf(__uint_as_float(e0 << 16) * vsl[i0]) << 16), c1 = __uint_as_float(f2bf(__uint_as_float(e1 << 16) * vsl[i1]) << 16);
            const float gm = wave_fmax_u(__builtin_fmaxf(__builtin_fabsf(c0), __builtin_fabsf(c1)));
            const float qinv = gm > 0.f ? 127.0f / gm : 0.f; Q[tok] = gm * (1.0f / 127.0f);
            const int k0 = (int)__builtin_rintf(c0 * qinv), k1 = (int)__builtin_rintf(c1 * qinv);
            { int t = k0 + k1; t += (int)dpp_u<0xB1>((unsigned)t); t += (int)dpp_u<0x4E>((unsigned)t); t += (int)dpp_u<0x124>((unsigned)t); t += (int)dpp_u<0x128>((unsigned)t);
              csum[tok] = (__builtin_amdgcn_readlane(t, 0) + __builtin_amdgcn_readlane(t, 16)) + (__builtin_amdgcn_readlane(t, 32) + __builtin_amdgcn_readlane(t, 48)); }
            const unsigned b0 = (unsigned)k0 & 255u, b1 = (unsigned)k1 & 255u;
            const unsigned w0 = dpp_u<0x00>(b0) | (dpp_u<0x55>(b0) << 8) | (dpp_u<0xAA>(b0) << 16) | (dpp_u<0xFF>(b0) << 24);
            const unsigned w1 = dpp_u<0x00>(b1) | (dpp_u<0x55>(b1) << 8) | (dpp_u<0xAA>(b1) << 16) | (dpp_u<0xFF>(b1) << 24);
            asm volatile("s_waitcnt lgkmcnt(0)" ::: "memory");
            if ((lane & 3) == 0) { cql[tok * 32 + (lane >> 2)] = w0; cql[tok * 32 + 16 + (lane >> 2)] = w1; } }
#pragma unroll 1
        for (int vh = 0; vh < 2; ++vh) {
            int accF[4][16], accL[4][16];
#pragma unroll
            for (int i = 0; i < 16; ++i) {
#pragma unroll
                for (int tok = 0; tok < 4; ++tok) { accF[tok][i] = 0; accL[tok][i] = 0; } }
            for (int blk = 0; blk < 8; ++blk) {
                int lane = F.lane; asm volatile("" : "+v"(lane));
                unsigned curv[4], nx[2];
#pragma unroll
                for (int tok = 0; tok < 4; ++tok) curv[tok] = ent_off(ent[tok * 128 + 16 * blk + (lane & 15)]);
#pragma unroll
                for (int tt = 0; tt < 2; ++tt) nx[tt] = ent_off(ent[tt * 128 + (blk < 7 ? 16 * (blk + 1) + (lane & 3) : (vh == 0 ? (lane & 3) : 127))]);
#pragma unroll
                for (int q4 = 0; q4 < 4; ++q4) {
#pragma unroll
                    for (int tok = 0; tok < 4; ++tok) {
                        constexpr int dummy = 0; (void)dummy;
                        const int sg = 4 * (tok & 1);
                        asm volatile("s_waitcnt vmcnt(4)" ::: "memory");
                        unsigned rw[4][4]; const unsigned cq = cql[tok * 32 + 4 * blk + q4];
#pragma unroll
                        for (int i = 0; i < 4; ++i) { const LAS unsigned char* sl = ring + (sg + i) * P5_SLOT;
                            const v4u a0 = ((const LAS v4u*)sl)[lane];
                            rw[i][0] = a0.x; rw[i][1] = a0.y; rw[i][2] = a0.z; rw[i][3] = a0.w; }
                        asm volatile("s_waitcnt lgkmcnt(0)" ::: "memory");
                        { const int tt = (tok + 2) & 3; int hoff = 1024 * vh; if (tok >= 2 && q4 == 3 && blk == 7 && vh == 0) hoff = 1024;
#pragma unroll
                          for (int i = 0; i < 4; ++i) {
                              const unsigned ne = (tok < 2) ? (unsigned)__builtin_amdgcn_readlane((int)curv[tt], 4 * q4 + i)
                                                : (q4 < 3) ? (unsigned)__builtin_amdgcn_readlane((int)curv[tt], 4 * (q4 + 1) + i) : (unsigned)__builtin_amdgcn_readlane((int)nx[tt], i);
                              if (i == 0) p5_dma_half_io<0>(F.VT + (size_t)ne, hoff, ring + sg * P5_SLOT, lane); else if (i == 1) p5_dma_half_io<1024>(F.VT + (size_t)ne, hoff, ring + sg * P5_SLOT, lane);
                              else if (i == 2) p5_dma_half_io<2048>(F.VT + (size_t)ne, hoff, ring + sg * P5_SLOT, lane); else p5_dma_half_io<3072>(F.VT + (size_t)ne, hoff, ring + sg * P5_SLOT, lane); } }
#pragma unroll
                        for (int j = 0; j < 4; ++j) {
                            const unsigned t01l = __builtin_amdgcn_perm(rw[1][j], rw[0][j], 0x05010400u), t01h = __builtin_amdgcn_perm(rw[1][j], rw[0][j], 0x07030602u);
                            const unsigned t23l = __builtin_amdgcn_perm(rw[3][j], rw[2][j], 0x05010400u), t23h = __builtin_amdgcn_perm(rw[3][j], rw[2][j], 0x07030602u);
                            const unsigned x0 = __builtin_amdgcn_perm(t23l, t01l, 0x05040100u), x1 = __builtin_amdgcn_perm(t23l, t01l, 0x07060302u);
                            const unsigned x2 = __builtin_amdgcn_perm(t23h, t01h, 0x05040100u), x3 = __builtin_amdgcn_perm(t23h, t01h, 0x07060302u);
                            accF[tok][4 * j + 0] = __builtin_amdgcn_sdot4((int)x0, (int)cq, accF[tok][4 * j + 0], false); accL[tok][4 * j + 0] = __builtin_amdgcn_sdot4((int)(x0 & 0x0F0F0F0Fu), (int)cq, accL[tok][4 * j + 0], false);
                            accF[tok][4 * j + 1] = __builtin_amdgcn_sdot4((int)x1, (int)cq, accF[tok][4 * j + 1], false); accL[tok][4 * j + 1] = __builtin_amdgcn_sdot4((int)(x1 & 0x0F0F0F0Fu), (int)cq, accL[tok][4 * j + 1], false);
                            accF[tok][4 * j + 2] = __builtin_amdgcn_sdot4((int)x2, (int)cq, accF[tok][4 * j + 2], false); accL[tok][4 * j + 2] = __builtin_amdgcn_sdot4((int)(x2 & 0x0F0F0F0Fu), (int)cq, accL[tok][4 * j + 2], false);
                            accF[tok][4 * j + 3] = __builtin_amdgcn_sdot4((int)x3, (int)cq, accF[tok][4 * j + 3], false); accL[tok][4 * j + 3] = __builtin_amdgcn_sdot4((int)(x3 & 0x0F0F0F0Fu), (int)cq, accL[tok][4 * j + 3], false);
                        }
                    }
                }
            }
#pragma unroll
            for (int tok = 0; tok < 4; ++tok) { const int t = 4 * g + tok; int lane = F.lane; asm volatile("" : "+v"(lane));
                const GAS v2u* hp = (const GAS v2u*)(F.HB + (size_t)t * DM) + lane + 512 * vh; GAS f32x4* op = (GAS f32x4*)(F.out + (size_t)t * DM) + lane + 512 * vh;
                const int corr = 8 * csum[tok]; const float Qe = Q[tok], Q16 = Q[tok] * 0.0625f;
#pragma unroll
                for (int jj = 0; jj < 8; ++jj) { const v2u q = __builtin_nontemporal_load(hp + 64 * jj); f32x4 a; const int b0 = 2 * jj, b1 = 2 * jj + 1;
                    a.x = bflo(q.x) + Qe * (float)(accL[tok][b0] - corr); a.y = bfhi(q.x) + Q16 * (float)(accF[tok][b0] - accL[tok][b0]);
                    a.z = bflo(q.y) + Qe * (float)(accL[tok][b1] - corr); a.w = bfhi(q.y) + Q16 * (float)(accF[tok][b1] - accL[tok][b1]);
                    __builtin_nontemporal_store(a, op + 64 * jj); } }
        }
        asm volatile("s_waitcnt vmcnt(0)" ::: "memory");
    }
}

struct Args { const float* in[16]; float* out; unsigned char* ws; int ph_lo, ph_hi, li, pad; };
__global__ void __launch_bounds__(NWAVES * 64, 2) mk_fwd(Args args) {
    extern __shared__ __attribute__((aligned(16))) unsigned char lds[];
    Frame F;
    F.lds = (LAS unsigned char*)lds;
    F.MISC = (volatile LAS unsigned*)(F.lds + MISC_OFF);
    F.tid = threadIdx.x; F.lane = F.tid & 63; F.wave = __builtin_amdgcn_readfirstlane(F.tid >> 6);
    F.G = gridDim.x; { const int bx = blockIdx.x; F.vcu = (F.G % 8 == 0) ? (bx % 8) * (F.G / 8) + bx / 8 : bx; }
    unsigned char* ws = args.ws;
    F.ctl = (gu32*)(ws + WS_CTL);
    F.x = args.in[0]; F.mix_g = args.in[1]; F.w_in = args.in[2]; F.q_g = args.in[3]; F.k_g = args.in[4]; F.sgu_vg = args.in[5]; F.sgu_w = args.in[6]; F.sgu_b = args.in[7];
    F.sb_og = args.in[8]; F.sgu_og = args.in[9]; F.w_out = args.in[10]; F.ffn_g = args.in[11]; F.w_q = args.in[12]; F.keys = args.in[13]; F.pu = args.in[14]; F.pv = args.in[15];
    F.out = args.out;
    F.XN = ws + WS_XN; F.WA = ws + WS_WA; F.WB = ws + WS_WB; F.MIXQ = ws + WS_MIXQ; F.WO = ws + WS_WO; F.WS = (bf16*)(ws + WS_WS);
    F.SA = (float*)(ws + WS_SCL); F.SWA = (float*)(ws + WS_SCL + 65536); F.SWB = (float*)(ws + WS_SCL + 131072); F.SA2 = (float*)(ws + WS_SCL + 196608); F.SWO = (float*)(ws + WS_SCL + 262144);
    F.QKU = (bf16*)(ws + WS_QKU); F.VG = (bf16*)(ws + WS_VG); F.MIX = (bf16*)(ws + WS_MIX); F.HB = (bf16*)(ws + WS_HB); F.UT = ws + WS_UT; F.VT = ws + WS_VT;
    F.GVP = (float*)(ws + WS_GVP); F.HSS = (float*)(ws + WS_HSS); F.SC = (float*)(ws + WS_SC); F.USC = (float*)(ws + WS_SCL + 327680); F.VSC = (float*)(ws + WS_SCL + 393216);
    for (int u = F.tid; u < (LDS_BYTES - LDSCTL_OFF) / 4; u += NWAVES * 64) ((LAS unsigned*)(F.lds + LDSCTL_OFF))[u] = 0u;
    __syncthreads();
    XcdBarrier bar; bar.bar = (unsigned*)(F.ctl + CW_BAR); bar.x = 0; bar.st = nullptr;
    if (N_LAUNCHES != PER_PHASE) bar = xcd_barrier_post((unsigned*)(F.ctl + CW_BAR), F.MISC + 8);
#define GRID_BAR() do { if (N_LAUNCHES != PER_PHASE) xcd_barrier(bar); } while (0)
    const int lo = args.ph_lo, hi = args.ph_hi;
#define IN(k) (lo <= (k) && (k) < hi)
#define BOTH(k) (IN(k) && IN((k) + 1))

    if (IN(0)) { p0_prologue(F); if (BOTH(0)) GRID_BAR(); }

    if (IN(1)) {
        { pg8::Gemm g{(const pg8::bf16_t*)F.XN, (const pg8::bf16_t*)F.WA, T, NA, DM / 2}; pg8::StaticOrder S; S.init(T, NA, F.G, (int)blockIdx.x);
          pg8::EpiQKU8 E{F.QKU, F.SA, F.SWA};
          pg8::gemm_phase<pg8::EpiQKU8, pg8::StaticOrder, true, true, true>(F.lds + RING_OFF, g, S, E); }
        { pg8::Gemm g{(const pg8::bf16_t*)F.WB, (const pg8::bf16_t*)F.XN, MB, T, DM / 2}; pg8::StaticOrder S; S.init(MB, T, F.G, (int)blockIdx.x);
          pg8::EpiVT8 E{F.VG, F.GVP, F.SWB, F.SA};
          pg8::gemm_phase<pg8::EpiVT8, pg8::StaticOrder, true, true, true>(F.lds + RING_OFF, g, S, E); }
        if (BOTH(1)) GRID_BAR();
    }

    if (IN(2)) { p2_mixers(F); if (BOTH(2)) GRID_BAR(); }

    if (IN(3)) {
        pg8::Gemm g{(const pg8::bf16_t*)F.MIXQ, (const pg8::bf16_t*)F.WO, T, DM, DM / 2}; pg8::StaticOrder S; S.init(T, DM, F.G, (int)blockIdx.x);
        pg8::EpiH8 E{F.x, F.HB, F.HSS, F.SA2, F.SWO};
        pg8::gemm_phase<pg8::EpiH8, pg8::StaticOrder, true, true, true>(F.lds + RING_OFF, g, S, E);
        if (BOTH(3)) GRID_BAR();
    }

    if (IN(4)) {
        pg8::Gemm g{F.HB, F.WS, T, NSC, DM}; pg8::StaticOrder S; S.init(T, NSC, F.G, (int)blockIdx.x);
        pg8::EpiF32 E{F.SC, NSC};
        pg8::gemm_phase<pg8::EpiF32, pg8::StaticOrder, false, true>(F.lds + RING_OFF, g, S, E);
        if (BOTH(4)) GRID_BAR();
    }

    if (IN(5)) { p5_peer(F, bar); }
#undef IN
#undef BOTH
}

extern "C" void kernel_launch(void* const* d_in, const int* in_sizes, int n_in, void* d_out, int out_size, void* d_ws, size_t ws_size, hipStream_t stream) {
    static int grid = 0;
    if (grid == 0) {
        if (n_in != 16 || in_sizes[0] != T * DM || out_size != T * DM || ws_size < WS_END) { fprintf(stderr, "kernel_launch: unexpected shapes (n_in %d, in0 %d, out %d, ws %zu); nothing launched\n", n_in, n_in > 0 ? in_sizes[0] : -1, out_size, ws_size); grid = -1; return; }
        int dev = 0, cus = 0, per_cu = 0;
        if (hipGetDevice(&dev) != hipSuccess || hipDeviceGetAttribute(&cus, hipDeviceAttributeMultiprocessorCount, dev) != hipSuccess) { grid = -1; return; }
        if (hipFuncSetAttribute((const void*)mk_fwd, hipFuncAttributeMaxDynamicSharedMemorySize, LDS_BYTES) != hipSuccess) { fprintf(stderr, "kernel_launch: hipFuncSetAttribute failed\n"); grid = -1; return; }
        if (hipOccupancyMaxActiveBlocksPerMultiprocessor(&per_cu, (const void*)mk_fwd, NWAVES * 64, LDS_BYTES) != hipSuccess || per_cu < 1) fprintf(stderr, "kernel_launch: occupancy query reports %d per CU\n", per_cu);
        (void)hipGetLastError();
        grid = cus < T / (4 * NWAVES) ? cus : T / (4 * NWAVES);
    }
    if (grid < 0) return;
    if (hipMemsetAsync((char*)d_ws + WS_CTL, 0, CTL_ZERO_BYTES, stream) != hipSuccess) return;
    Args a{};
    for (int i = 0; i < 16; ++i) a.in[i] = (const float*)d_in[i];
    a.out = (float*)d_out; a.ws = (unsigned char*)d_ws;
    if (N_LAUNCHES == 1) {
        a.ph_lo = 0; a.ph_hi = PER_PHASE; a.li = 0;
        void* kargs[] = {&a};
        hipError_t e = hipLaunchCooperativeKernel((const void*)mk_fwd, dim3(grid), dim3(NWAVES * 64), kargs, LDS_BYTES, stream);
        if (e != hipSuccess) fprintf(stderr, "kernel_launch: cooperative launch failed: %s (grid %d)\n", hipGetErrorString(e), grid);
    } else {
        for (int li = 0; li < PER_PHASE; ++li) {
            a.ph_lo = li; a.ph_hi = li + 1; a.li = li;
            hipLaunchKernelGGL(mk_fwd, dim3(grid), dim3(NWAVES * 64), LDS_BYTES, stream, a);
        }
    }
}
```

```cpp
#include <hip/hip_runtime.h>
#include <cstdio>
#include <cstdint>

#ifndef MK_N_LAUNCHES
#define MK_N_LAUNCHES 1
#endif

namespace pg8 {
#define PG8_LAS __attribute__((address_space(3)))
typedef unsigned short bf16_t;
typedef short bf16x8 __attribute__((ext_vector_type(8)));
typedef float f32x4 __attribute__((ext_vector_type(4)));
typedef float f32x2 __attribute__((ext_vector_type(2)));
typedef unsigned u32x4 __attribute__((ext_vector_type(4)));
typedef unsigned u32x2 __attribute__((ext_vector_type(2)));
typedef int i32x4 __attribute__((ext_vector_type(4)));
template <bool I8> struct AccT { typedef f32x4 type; };
template <> struct AccT<true> { typedef i32x4 type; };
constexpr int BM = 256, BK = 64, HALF = 128, HTB = HALF * BK * 2, STAGE_BYTES = 8 * HTB, NXCD = 8, WGM = 8;

__host__ __device__ __forceinline__ int lds_byte(int r, int c) { const int st = (r >> 4) * 2 + (c >> 5), rr = r & 15, cc = c & 31, ob = rr * 64 + cc * 2; return st * 1024 + (ob ^ (((ob >> 9) & 1) << 5)); }
__host__ __device__ __forceinline__ void stage_rc(int b, int& R, int& C) { const int st = b / 1024, sb = b % 1024, swz = sb ^ (((sb >> 9) & 1) << 5); R = (st >> 1) * 16 + swz / 64; C = (st & 1) * 32 + (swz % 64) / 2; }
__host__ __device__ __forceinline__ int perm32(int rho) { const int n = rho >> 4, i = rho & 15; return 8 * (i >> 2) + 4 * n + (i & 3); }

struct Unit { int pm, pn; };
struct Gemm { const bf16_t* A; const bf16_t* Bt; int M, N, K; };

struct StaticOrder {
    int nM, nN, nwg, G, c;
    __host__ __device__ void init(int M, int N, int G_, int c_) { nM = M / BM; nN = N / BM; nwg = nM * nN; G = G_; c = c_; }
    __host__ __device__ bool next(int i, Unit& u) const {
        const long L = (long)i * G + c; if (L >= nwg) return false;
        int wgid = (int)L; { const int q = nwg / NXCD, r = nwg % NXCD, xcd = wgid % NXCD, off = wgid / NXCD; wgid = (xcd < r ? xcd * (q + 1) : r * (q + 1) + (xcd - r) * q) + off; }
        const int nig = WGM * nN, gid = wgid / nig, fm = gid * WGM, gsz = (nM - fm) < WGM ? (nM - fm) : WGM;
        u.pm = fm + ((wgid % nig) % gsz); u.pn = (wgid % nig) / gsz; return true;
    }
    __device__ __forceinline__ void a_ready(const Unit&) const {}
    __device__ __forceinline__ void done(const Unit&) const {}
};

__device__ __forceinline__ unsigned cvt_pk_bf16(float lo, float hi) { unsigned r; asm volatile("v_cvt_pk_bf16_f32 %0, %1, %2" : "=v"(r) : "v"(lo), "v"(hi)); return r; }
__device__ __forceinline__ float gelu_tanh(float x) {
    const float t = x * (1.0f + 0.044715f * x * x) * (-2.3022081985f);
    return x * __builtin_amdgcn_rcpf(1.0f + __builtin_amdgcn_exp2f(t));
}

struct EpiQKU {
    static constexpr bool PERM = true, AFTER_DRAIN = false;
    bf16_t* O;
    __device__ __forceinline__ void operator()(const f32x4 (&acc)[2][2][4][2], const Unit& u, int wr, int wc, int fr, int fq) const {
        const int row0 = u.pm * BM + wr * 64 + fr; const int t = u.pn >> 3; const int colt = (u.pn & 7) * BM;
        bf16_t* base = O + (size_t)t * ((size_t)8192 * 2048); const int col0 = colt + wc * 32 + 8 * fq;
#pragma unroll
        for (int ai = 0; ai < 2; ++ai)
#pragma unroll
            for (int m = 0; m < 4; ++m) { bf16_t* rowp = base + (size_t)(row0 + ai * HALF + m * 16) * 2048 + col0;
#pragma unroll
                for (int bj = 0; bj < 2; ++bj) { f32x4 v0 = acc[ai][bj][m][0], v1 = acc[ai][bj][m][1];
                    if (t == 2) {
#pragma unroll
                        for (int j = 0; j < 4; ++j) { v0[j] = gelu_tanh(v0[j]); v1[j] = gelu_tanh(v1[j]); } }
                    u32x4 w; w.x = cvt_pk_bf16(v0[0], v0[1]); w.y = cvt_pk_bf16(v0[2], v0[3]); w.z = cvt_pk_bf16(v1[0], v1[1]); w.w = cvt_pk_bf16(v1[2], v1[3]);
                    *(u32x4*)(rowp + bj * HALF) = w; } }
    }
};
struct EpiVT {
    static constexpr bool PERM = true, AFTER_DRAIN = false;
    bf16_t* O; float* part;
    __device__ __forceinline__ void operator()(const f32x4 (&acc)[2][2][4][2], const Unit& u, int wr, int wc, int fr, int fq) const {
        const int row0 = u.pm * BM + wr * 64 + fr, col0 = u.pn * BM + wc * 32 + 8 * fq; const bool sg = u.pm >= 8;
#pragma unroll
        for (int ai = 0; ai < 2; ++ai) {
            f32x4 cs[2][2];
#pragma unroll
            for (int bj = 0; bj < 2; ++bj) { cs[bj][0] = (f32x4){0.f, 0.f, 0.f, 0.f}; cs[bj][1] = (f32x4){0.f, 0.f, 0.f, 0.f}; }
#pragma unroll
            for (int m = 0; m < 4; ++m) { bf16_t* rowp = O + (size_t)(row0 + ai * HALF + m * 16) * 8192 + col0;
#pragma unroll
                for (int bj = 0; bj < 2; ++bj) { f32x4 v0 = acc[ai][bj][m][0], v1 = acc[ai][bj][m][1];
                    if (sg) {
#pragma unroll
                        for (int j = 0; j < 4; ++j) { v0[j] = gelu_tanh(v0[j]); v1[j] = gelu_tanh(v1[j]); }
                        cs[bj][0] += v0 * v0; cs[bj][1] += v1 * v1; }
                    u32x4 w; w.x = cvt_pk_bf16(v0[0], v0[1]); w.y = cvt_pk_bf16(v0[2], v0[3]); w.z = cvt_pk_bf16(v1[0], v1[1]); w.w = cvt_pk_bf16(v1[2], v1[3]);
                    *(u32x4*)(rowp + bj * HALF) = w; } }
            if (sg) {
                const int g = (u.pm - 8) * 2 + ai;
#pragma unroll
                for (int bj = 0; bj < 2; ++bj)
#pragma unroll
                    for (int n = 0; n < 2; ++n) { f32x4 s = cs[bj][n];
#pragma unroll
                        for (int j = 0; j < 4; ++j) { float v = s[j];
                            v += __uint_as_float((unsigned)__builtin_amdgcn_update_dpp(0, (int)__float_as_uint(v), 0xB1, 0xF, 0xF, false)); v += __uint_as_float((unsigned)__builtin_amdgcn_update_dpp(0, (int)__float_as_uint(v), 0x4E, 0xF, 0xF, false));
                            v += __uint_as_float((unsigned)__builtin_amdgcn_update_dpp(0, (int)__float_as_uint(v), 0x124, 0xF, 0xF, false)); v += __uint_as_float((unsigned)__builtin_amdgcn_update_dpp(0, (int)__float_as_uint(v), 0x128, 0xF, 0xF, false)); s[j] = v; }
                        if (fr == 0) *(f32x4*)(part + ((size_t)wr * 16 + g) * 8192 + col0 + bj * HALF + 4 * n) = s; }
            }
        }
    }
};
struct EpiQKU8 {
    static constexpr bool PERM = true, AFTER_DRAIN = false;
    bf16_t* O; const float* srow; const float* scol;
    __device__ __forceinline__ void operator()(const i32x4 (&acc)[2][2][4][2], const Unit& u, int wr, int wc, int fr, int fq) const {
        const int row0 = u.pm * BM + wr * 64 + fr; const int t = u.pn >> 3; const int colt = (u.pn & 7) * BM;
        bf16_t* base = O + (size_t)t * ((size_t)8192 * 2048); const int col0 = colt + wc * 32 + 8 * fq, gcol0 = u.pn * BM + wc * 32 + 8 * fq;
        f32x4 sc[2][2];
#pragma unroll
        for (int bj = 0; bj < 2; ++bj) { sc[bj][0] = *(const f32x4*)(scol + gcol0 + bj * HALF); sc[bj][1] = *(const f32x4*)(scol + gcol0 + bj * HALF + 4); }
#pragma unroll
        for (int ai = 0; ai < 2; ++ai)
#pragma unroll
            for (int m = 0; m < 4; ++m) { const int row = row0 + ai * HALF + m * 16; const float sr = srow[row]; bf16_t* rowp = base + (size_t)row * 2048 + col0;
#pragma unroll
                for (int bj = 0; bj < 2; ++bj) { f32x4 v0, v1;
#pragma unroll
                    for (int j = 0; j < 4; ++j) { v0[j] = (float)acc[ai][bj][m][0][j] * sr * sc[bj][0][j]; v1[j] = (float)acc[ai][bj][m][1][j] * sr * sc[bj][1][j]; }
                    if (t == 2) {
#pragma unroll
                        for (int j = 0; j < 4; ++j) { v0[j] = gelu_tanh(v0[j]); v1[j] = gelu_tanh(v1[j]); } }
                    u32x4 w; w.x = cvt_pk_bf16(v0[0], v0[1]); w.y = cvt_pk_bf16(v0[2], v0[3]); w.z = cvt_pk_bf16(v1[0], v1[1]); w.w = cvt_pk_bf16(v1[2], v1[3]);
                    *(u32x4*)(rowp + bj * HALF) = w; } }
    }
};
struct EpiVT8 {
    static constexpr bool PERM = true, AFTER_DRAIN = false;
    bf16_t* O; float* part; const float* srow; const float* scol;
    __device__ __forceinline__ void operator()(const i32x4 (&acc)[2][2][4][2], const Unit& u, int wr, int wc, int fr, int fq) const {
        const int row0 = u.pm * BM + wr * 64 + fr, col0 = u.pn * BM + wc * 32 + 8 * fq; const bool sg = u.pm >= 8;
        f32x4 sc[2][2];
#pragma unroll
        for (int bj = 0; bj < 2; ++bj) { sc[bj][0] = *(const f32x4*)(scol + col0 + bj * HALF); sc[bj][1] = *(const f32x4*)(scol + col0 + bj * HALF + 4); }
#pragma unroll
        for (int ai = 0; ai < 2; ++ai) {
            f32x4 cs[2][2];
#pragma unroll
            for (int bj = 0; bj < 2; ++bj) { cs[bj][0] = (f32x4){0.f, 0.f, 0.f, 0.f}; cs[bj][1] = (f32x4){0.f, 0.f, 0.f, 0.f}; }
#pragma unroll
            for (int m = 0; m < 4; ++m) { const int row = row0 + ai * HALF + m * 16; const float sr = srow[row]; bf16_t* rowp = O + (size_t)row * 8192 + col0;
#pragma unroll
                for (int bj = 0; bj < 2; ++bj) { f32x4 v0, v1;
#pragma unroll
                    for (int j = 0; j < 4; ++j) { v0[j] = (float)acc[ai][bj][m][0][j] * sr * sc[bj][0][j]; v1[j] = (float)acc[ai][bj][m][1][j] * sr * sc[bj][1][j]; }
                    if (sg) {
#pragma unroll
                        for (int j = 0; j < 4; ++j) { v0[j] = gelu_tanh(v0[j]); v1[j] = gelu_tanh(v1[j]); }
                        cs[bj][0] += v0 * v0; cs[bj][1] += v1 * v1; }
                    u32x4 w; w.x = cvt_pk_bf16(v0[0], v0[1]); w.y = cvt_pk_bf16(v0[2], v0[3]); w.z = cvt_pk_bf16(v1[0], v1[1]); w.w = cvt_pk_bf16(v1[2], v1[3]);
                    *(u32x4*)(rowp + bj * HALF) = w; } }
            if (sg) {
                const int g = (u.pm - 8) * 2 + ai;
#pragma unroll
                for (int bj = 0; bj < 2; ++bj)
#pragma unroll
                    for (int n = 0; n < 2; ++n) { f32x4 s = cs[bj][n];
#pragma unroll
                        for (int j = 0; j < 4; ++j) { float v = s[j];
                            v += __uint_as_float((unsigned)__builtin_amdgcn_update_dpp(0, (int)__float_as_uint(v), 0xB1, 0xF, 0xF, false)); v += __uint_as_float((unsigned)__builtin_amdgcn_update_dpp(0, (int)__float_as_uint(v), 0x4E, 0xF, 0xF, false));
                            v += __uint_as_float((unsigned)__builtin_amdgcn_update_dpp(0, (int)__float_as_uint(v), 0x124, 0xF, 0xF, false)); v += __uint_as_float((unsigned)__builtin_amdgcn_update_dpp(0, (int)__float_as_uint(v), 0x128, 0xF, 0xF, false)); s[j] = v; }
                        if (fr == 0) *(f32x4*)(part + ((size_t)wr * 16 + g) * 8192 + col0 + bj * HALF + 4 * n) = s; }
            }
        }
    }
};
struct EpiH {
    static constexpr bool PERM = true, AFTER_DRAIN = false;
    const float* x; bf16_t* hb; float* hss;
    __device__ __forceinline__ void operator()(const f32x4 (&acc)[2][2][4][2], const Unit& u, int wr, int wc, int fr, int fq) const {
        const int row0 = u.pm * BM + wr * 64 + fr, col0 = u.pn * BM + wc * 32 + 8 * fq;
#pragma unroll
        for (int ai = 0; ai < 2; ++ai)
#pragma unroll
            for (int m = 0; m < 4; ++m) { const int row = row0 + ai * HALF + m * 16; const size_t off = (size_t)row * 4096 + col0; float ss = 0.f;
#pragma unroll
                for (int bj = 0; bj < 2; ++bj) { const f32x4 x0 = *(const f32x4*)(x + off + bj * HALF), x1 = *(const f32x4*)(x + off + bj * HALF + 4);
                    const f32x4 h0 = x0 + acc[ai][bj][m][0], h1 = x1 + acc[ai][bj][m][1];
                    ss += (h0[0] * h0[0] + h0[1] * h0[1]) + (h0[2] * h0[2] + h0[3] * h0[3]) + (h1[0] * h1[0] + h1[1] * h1[1]) + (h1[2] * h1[2] + h1[3] * h1[3]);
                    u32x4 w; w.x = cvt_pk_bf16(h0[0], h0[1]); w.y = cvt_pk_bf16(h0[2], h0[3]); w.z = cvt_pk_bf16(h1[0], h1[1]); w.w = cvt_pk_bf16(h1[2], h1[3]);
                    *(u32x4*)(hb + off + bj * HALF) = w; }
                ss += __shfl_xor(ss, 16); ss += __shfl_xor(ss, 32);
                if (fq == 0) hss[(size_t)(u.pn * 4 + wc) * 8192 + row] = ss;
                if (m == 3) asm volatile("" ::: "memory"); }
    }
};
struct EpiH8 {
    static constexpr bool PERM = true, AFTER_DRAIN = false;
    const float* x; bf16_t* hb; float* hss; const float* srow; const float* scol;
    __device__ __forceinline__ void operator()(const i32x4 (&acc)[2][2][4][2], const Unit& u, int wr, int wc, int fr, int fq) const {
        const int row0 = u.pm * BM + wr * 64 + fr, col0 = u.pn * BM + wc * 32 + 8 * fq;
        f32x4 sc[2][2];
#pragma unroll
        for (int bj = 0; bj < 2; ++bj) { sc[bj][0] = *(const f32x4*)(scol + col0 + bj * HALF); sc[bj][1] = *(const f32x4*)(scol + col0 + bj * HALF + 4); }
#pragma unroll
        for (int ai = 0; ai < 2; ++ai)
#pragma unroll
            for (int m = 0; m < 4; ++m) { const int row = row0 + ai * HALF + m * 16; const size_t off = (size_t)row * 4096 + col0; float ss = 0.f; const float sr = srow[row];
#pragma unroll
                for (int bj = 0; bj < 2; ++bj) { const f32x4 x0 = *(const f32x4*)(x + off + bj * HALF), x1 = *(const f32x4*)(x + off + bj * HALF + 4);
                    f32x4 h0, h1;
#pragma unroll
                    for (int j = 0; j < 4; ++j) { h0[j] = x0[j] + (float)acc[ai][bj][m][0][j] * sr * sc[bj][0][j]; h1[j] = x1[j] + (float)acc[ai][bj][m][1][j] * sr * sc[bj][1][j]; }
                    ss += (h0[0] * h0[0] + h0[1] * h0[1]) + (h0[2] * h0[2] + h0[3] * h0[3]) + (h1[0] * h1[0] + h1[1] * h1[1]) + (h1[2] * h1[2] + h1[3] * h1[3]);
                    u32x4 w; w.x = cvt_pk_bf16(h0[0], h0[1]); w.y = cvt_pk_bf16(h0[2], h0[3]); w.z = cvt_pk_bf16(h1[0], h1[1]); w.w = cvt_pk_bf16(h1[2], h1[3]);
                    *(u32x4*)(hb + off + bj * HALF) = w; }
                ss += __shfl_xor(ss, 16); ss += __shfl_xor(ss, 32);
                if (fq == 0) hss[(size_t)(u.pn * 4 + wc) * 8192 + row] = ss;
                if (m == 3) asm volatile("" ::: "memory"); }
    }
};
struct EpiF32 {
    static constexpr bool PERM = false, AFTER_DRAIN = false;
    float* C; int ldc;
    __device__ __forceinline__ void operator()(const f32x4 (&acc)[2][2][4][2], const Unit& u, int wr, int wc, int fr, int fq) const {
        const int row0 = u.pm * BM + wr * 64 + fr, col0 = u.pn * BM + wc * 32 + 4 * fq;
#pragma unroll
        for (int ai = 0; ai < 2; ++ai)
#pragma unroll
            for (int m = 0; m < 4; ++m) { float* rowp = C + (size_t)(row0 + ai * HALF + m * 16) * ldc + col0;
#pragma unroll
                for (int bj = 0; bj < 2; ++bj)
#pragma unroll
                    for (int n = 0; n < 2; ++n) *(f32x4*)(rowp + bj * HALF + n * 16) = acc[ai][bj][m][n]; }
    }
};

template <class Epi, class Sched, bool ALIGN_EPI = false, bool SP2 = false, bool I8 = false>
__device__ __forceinline__ void gemm_phase(PG8_LAS unsigned char* lds, const Gemm g, const Sched& S, const Epi& E) {
    const int tid = threadIdx.x, wid = __builtin_amdgcn_readfirstlane(tid >> 6), lane = tid & 63, wr = wid >> 2, wc = wid & 3, fr = lane & 15, fq = lane >> 4;
    const int K = g.K, nt = K / BK;
    unsigned voffA[2], voffB[2];
#pragma unroll
    for (int i = 0; i < 2; ++i) { int R, C; stage_rc(tid * 16 + i * 8192, R, C); const int Rb = Epi::PERM ? ((R & ~31) + perm32(R & 31)) : R;
        voffA[i] = (unsigned)(R * K + C) * 2u; voffB[i] = (unsigned)(Rb * K + C) * 2u; }
    const size_t kstep = (size_t)(BK * 2);
    const size_t hstep = (size_t)HALF * K * 2;
    const size_t tstep = 2 * hstep;
    const unsigned ldsw = (unsigned)wid * 1024u;
    const int aoff = lds_byte(wr * 64 + fr, fq * 8), boff = lds_byte(wc * 32 + fr, fq * 8);
#define PG8_SA(b, h) (((b) * 2 + (h)) * HTB)
#define PG8_SB(b, h) ((4 + (b) * 2 + (h)) * HTB)
#define PG8_STAGE(bufoff, gbase, voff) do { _Pragma("unroll") for (int _i = 0; _i < 2; ++_i) \
        __builtin_amdgcn_global_load_lds((const unsigned*)((const char*)(gbase) + (voff)[_i]), (PG8_LAS unsigned*)(lds + (bufoff) + ldsw + _i * 8192), 16, 0, 0); } while (0)
#define PG8_LDA(dst, b, h) do { _Pragma("unroll") for (int m = 0; m < 4; ++m) _Pragma("unroll") for (int k = 0; k < 2; ++k) dst[m][k] = *(const PG8_LAS bf16x8*)(lds + PG8_SA(b, h) + aoff + m * 2048 + k * 1024); } while (0)
#define PG8_LDB(dst, b, h) do { _Pragma("unroll") for (int n = 0; n < 2; ++n) _Pragma("unroll") for (int k = 0; k < 2; ++k) dst[n][k] = *(const PG8_LAS bf16x8*)(lds + PG8_SB(b, h) + boff + n * 2048 + k * 1024); } while (0)
#define PG8_MMA(ai, bj, At, Bt) do { __builtin_amdgcn_s_setprio(1); _Pragma("unroll") for (int m = 0; m < 4; ++m) _Pragma("unroll") for (int n = 0; n < 2; ++n) _Pragma("unroll") for (int k = 0; k < 2; ++k) { \
        if constexpr (I8) acc[ai][bj][m][n] = __builtin_amdgcn_mfma_i32_16x16x64_i8(__builtin_bit_cast(i32x4, Bt[n][k]), __builtin_bit_cast(i32x4, At[m][k]), acc[ai][bj][m][n], 0, 0, 0); \
        else acc[ai][bj][m][n] = __builtin_amdgcn_mfma_f32_16x16x32_bf16(Bt[n][k], At[m][k], acc[ai][bj][m][n], 0, 0, 0); } __builtin_amdgcn_s_setprio(0); } while (0)
#define PG8_WAIT_V(n) asm volatile("s_waitcnt vmcnt(" #n ")" ::: "memory")
#define PG8_WAIT_L(n) asm volatile("s_waitcnt lgkmcnt(" #n ")" ::: "memory")
#define PG8_BAR __builtin_amdgcn_s_barrier()
#define PG8_SCHED __builtin_amdgcn_sched_barrier(0)
    Unit cur, nxt; int ui = 0;
    if (!S.next(0, cur)) return;
    typedef typename AccT<I8>::type acc_t;
    acc_t acc[2][2][4][2];
#pragma unroll
    for (int a = 0; a < 2; ++a)
#pragma unroll
        for (int b = 0; b < 2; ++b)
#pragma unroll
            for (int m = 0; m < 4; ++m)
#pragma unroll
                for (int n = 0; n < 2; ++n) acc[a][b][m][n] = (acc_t){0, 0, 0, 0};
    bf16x8 At[4][2], B0[2][2], B1[2][2];
    const char* cA = (const char*)g.A + (size_t)cur.pm * tstep; const char* cB = (const char*)g.Bt + (size_t)cur.pn * tstep;
    S.a_ready(cur);
    if constexpr (SP2) {
        PG8_STAGE(PG8_SB(0, 0), cB, voffB); PG8_STAGE(PG8_SB(0, 1), cB + hstep, voffB); PG8_STAGE(PG8_SA(0, 0), cA, voffA); PG8_STAGE(PG8_SA(0, 1), cA + hstep, voffA);
        if (wr == 1) PG8_BAR;
        PG8_WAIT_V(2); PG8_BAR;
        PG8_STAGE(PG8_SB(1, 0), cB + kstep, voffB); PG8_STAGE(PG8_SA(1, 0), cA + kstep, voffA); PG8_STAGE(PG8_SB(1, 1), cB + hstep + kstep, voffB);
        PG8_WAIT_V(6); PG8_BAR;
    } else {
        PG8_STAGE(PG8_SB(0, 0), cB, voffB); PG8_STAGE(PG8_SA(0, 0), cA, voffA); PG8_STAGE(PG8_SB(0, 1), cB + hstep, voffB); PG8_STAGE(PG8_SA(0, 1), cA + hstep, voffA);
        if (wr == 1) PG8_BAR;
        PG8_WAIT_V(4); PG8_BAR;
        PG8_STAGE(PG8_SB(1, 0), cB + kstep, voffB); PG8_STAGE(PG8_SA(1, 0), cA + kstep, voffA); PG8_STAGE(PG8_SB(1, 1), cB + hstep + kstep, voffB);
        PG8_WAIT_V(6); PG8_BAR;
    }
    for (;;) {
        const bool has_next = S.next(ui + 1, nxt);
        const char* nA = has_next ? (const char*)g.A + (size_t)nxt.pm * tstep : cA; const char* nB = has_next ? (const char*)g.Bt + (size_t)nxt.pn * tstep : cB;
        for (int t = 0; t < nt; t += 2) {
            const bool last = (t == nt - 2);
            const char* a1 = cA + (size_t)(t + 1) * kstep;
            const char* a2 = last ? nA : cA + (size_t)(t + 2) * kstep; const char* b2 = last ? nB : cB + (size_t)(t + 2) * kstep;
            const char* a3 = a2 + kstep; const char* b3 = b2 + kstep;
            if (last && has_next) S.a_ready(nxt);
            if constexpr (SP2) {
            PG8_LDB(B0, 0, 0); PG8_LDB(B1, 0, 1); PG8_SCHED; PG8_LDA(At, 0, 0); PG8_STAGE(PG8_SA(1, 1), a1 + hstep, voffA);
            PG8_WAIT_V(8); PG8_WAIT_L(0); PG8_BAR; PG8_MMA(0, 0, At, B0); PG8_MMA(0, 1, At, B1); PG8_BAR; PG8_SCHED;
            PG8_LDA(At, 0, 1); PG8_STAGE(PG8_SB(0, 0), b2, voffB); PG8_STAGE(PG8_SB(0, 1), b2 + hstep, voffB); PG8_STAGE(PG8_SA(0, 0), a2, voffA);
            PG8_WAIT_V(8); PG8_WAIT_L(0); PG8_BAR; PG8_MMA(1, 0, At, B0); PG8_MMA(1, 1, At, B1); PG8_BAR; PG8_SCHED;
            PG8_LDB(B0, 1, 0); PG8_LDB(B1, 1, 1); PG8_SCHED; PG8_LDA(At, 1, 0); PG8_STAGE(PG8_SA(0, 1), a2 + hstep, voffA);
            PG8_WAIT_V(8); PG8_WAIT_L(0); PG8_BAR; PG8_MMA(0, 0, At, B0); PG8_MMA(0, 1, At, B1); PG8_BAR; PG8_SCHED;
            PG8_LDA(At, 1, 1); PG8_STAGE(PG8_SB(1, 0), b3, voffB); PG8_STAGE(PG8_SB(1, 1), b3 + hstep, voffB); PG8_STAGE(PG8_SA(1, 0), a3, voffA);
            PG8_WAIT_V(8); PG8_WAIT_L(0); PG8_BAR; PG8_MMA(1, 0, At, B0); PG8_MMA(1, 1, At, B1); PG8_BAR; PG8_SCHED;
            } else {
            PG8_LDB(B0, 0, 0); PG8_SCHED; PG8_LDA(At, 0, 0); PG8_STAGE(PG8_SA(1, 1), a1 + hstep, voffA);
            PG8_WAIT_L(8); PG8_BAR; PG8_WAIT_L(0); PG8_MMA(0, 0, At, B0); PG8_BAR; PG8_SCHED;
            PG8_LDB(B1, 0, 1); PG8_STAGE(PG8_SB(0, 0), b2, voffB);
            PG8_BAR; PG8_WAIT_L(0); PG8_MMA(0, 1, At, B1); PG8_BAR;
            PG8_LDA(At, 0, 1); PG8_STAGE(PG8_SA(0, 0), a2, voffA);
            PG8_BAR; PG8_WAIT_L(0); PG8_MMA(1, 0, At, B0); PG8_BAR; PG8_SCHED;
            PG8_STAGE(PG8_SB(0, 1), b2 + hstep, voffB);
            PG8_WAIT_V(6); PG8_BAR; PG8_MMA(1, 1, At, B1); PG8_BAR;
            PG8_LDB(B0, 1, 0); PG8_SCHED; PG8_LDA(At, 1, 0); PG8_STAGE(PG8_SA(0, 1), a2 + hstep, voffA);
            PG8_WAIT_L(8); PG8_BAR; PG8_WAIT_L(0); PG8_MMA(0, 0, At, B0); PG8_BAR; PG8_SCHED;
            PG8_LDB(B1, 1, 1); PG8_STAGE(PG8_SB(1, 0), b3, voffB);
            PG8_BAR; PG8_WAIT_L(0); PG8_MMA(0, 1, At, B1); PG8_BAR;
            PG8_LDA(At, 1, 1); PG8_STAGE(PG8_SA(1, 0), a3, voffA);
            PG8_BAR; PG8_WAIT_L(0); PG8_MMA(1, 0, At, B0); PG8_BAR; PG8_SCHED;
            PG8_STAGE(PG8_SB(1, 1), b3 + hstep, voffB);
            PG8_WAIT_V(6); PG8_BAR; PG8_MMA(1, 1, At, B1); PG8_BAR;
            }
        }
        if constexpr (ALIGN_EPI) { if (wr == 0) PG8_BAR; }
        if constexpr (!Epi::AFTER_DRAIN) { E(acc, cur, wr, wc, fr, fq); S.done(cur); }
        if (!has_next) break;
#pragma unroll
        for (int a = 0; a < 2; ++a)
#pragma unroll
            for (int b = 0; b < 2; ++b)
#pragma unroll
                for (int m = 0; m < 4; ++m)
#pragma unroll
                    for (int n = 0; n < 2; ++n) acc[a][b][m][n] = (acc_t){0, 0, 0, 0};
        cur = nxt; cA = nA; cB = nB; ++ui;
        if constexpr (ALIGN_EPI) { if (wr == 1) PG8_BAR; }
    }
    PG8_WAIT_V(0);
    if constexpr (!ALIGN_EPI) { if (wr == 0) PG8_BAR; }
    PG8_BAR;
#undef PG8_SA
#undef PG8_SB
#undef PG8_STAGE
#undef PG8_LDA
#undef PG8_LDB
#undef PG8_MMA
#undef PG8_WAIT_V
#undef PG8_WAIT_L
#undef PG8_BAR
#undef PG8_SCHED
}
}

constexpr int NWAVES = 8;
constexpr int N_LAUNCHES = MK_N_LAUNCHES; static_assert(N_LAUNCHES == 1, "one launch");
constexpr int PER_PHASE = 6;
constexpr int T = 8192, DM = 4096, SBW = 2048, NHEAD = 16, HD = 128, NGRP = 16;
constexpr int NA = 6144, MB = 4096;
constexpr int PH = 8, PNK = 128, PHALF = 256, PK = 16, NEXP = 16384, NSC = 2048;
constexpr float EPS = 1e-6f;
constexpr float ATT_EXIT = 48.0f;
constexpr float QSCALE = 0.08838834764831845f * 1.4426950408889634f;

constexpr size_t MiB = 1u << 20;
constexpr size_t WS_CTL = 0, CTL_ZERO_BYTES = 1 * MiB;
constexpr size_t WS_XN = 1 * MiB;
constexpr size_t WS_WA = 65 * MiB;
constexpr size_t WS_WB = 113 * MiB;
constexpr size_t WS_WO = 145 * MiB;
constexpr size_t WS_WS = 177 * MiB;
constexpr size_t WS_QKU = 193 * MiB;
constexpr size_t WS_VG = 289 * MiB;
constexpr size_t WS_GVP = 353 * MiB;
constexpr size_t WS_MIX = 354 * MiB;
constexpr size_t WS_HB = 418 * MiB;
constexpr size_t WS_HSS = 482 * MiB;
constexpr size_t WS_SC = 484 * MiB;
constexpr int TROW = 2048;
static_assert((size_t)16384 * TROW <= 36 * MiB, "table size");
constexpr size_t WS_UT = 548 * MiB;
constexpr size_t WS_VT = 584 * MiB;
constexpr size_t WS_MIXQ = 33 * MiB;
constexpr size_t WS_SCL = 620 * MiB;
constexpr size_t WS_END = 621 * MiB;
constexpr int CW_TMO = 0, CW_CODE = 1, CW_TOK = 2, CW_SCMAX = 64;
constexpr int CW_BAR = 4096;

constexpr int RING_OFF = 0, RING_BYTES = 131072;
constexpr int P5_LIST_OFF = 147456;
constexpr int LDSCTL_OFF = 155648, MISC_OFF = LDSCTL_OFF + 320;
constexpr int LDS_BYTES = 163840;

#define GAS __attribute__((address_space(1)))
#define LAS __attribute__((address_space(3)))
#define DI __device__ __forceinline__
typedef unsigned short bf16;
typedef unsigned v4u __attribute__((ext_vector_type(4)));
typedef unsigned v2u __attribute__((ext_vector_type(2)));
typedef float f32x4 __attribute__((ext_vector_type(4)));
typedef float f32x2 __attribute__((ext_vector_type(2)));
typedef float f32x16 __attribute__((ext_vector_type(16)));
typedef short bf16x8 __attribute__((ext_vector_type(8)));
typedef __bf16 bf16x2_t __attribute__((ext_vector_type(2)));
typedef GAS unsigned gu32;
#define RLX_AGENT __ATOMIC_RELAXED, __HIP_MEMORY_SCOPE_AGENT
#define LDS_WAIT() asm volatile("s_waitcnt lgkmcnt(0)" ::: "memory")
#define VM_WAIT() asm volatile("s_waitcnt vmcnt(0)" ::: "memory")
#define MFMA32(a, b, c) __builtin_amdgcn_mfma_f32_32x32x16_bf16((a), (b), (c), 0, 0, 0)

DI unsigned f2bf(float f) { unsigned u = __builtin_bit_cast(unsigned, f); return (u + 0x7fffu + ((u >> 16) & 1u)) >> 16; }
DI unsigned pk2(float lo, float hi) { f32x2 v = {lo, hi}; bf16x2_t b = __builtin_convertvector(v, bf16x2_t); return __builtin_bit_cast(unsigned, b); }
DI float bflo(unsigned u) { return __uint_as_float(u << 16); }
DI float bfhi(unsigned u) { return __uint_as_float(u & 0xffff0000u); }
DI int crow(int i, int h) { return (i & 3) + 8 * (i >> 2) + 4 * h; }
DI float swap_add(float x) { auto rr = __builtin_amdgcn_permlane32_swap(__float_as_uint(x), __float_as_uint(x), false, false); return __uint_as_float(rr[0]) + __uint_as_float(rr[1]); }
DI float dot2bf(unsigned a, unsigned b, float c) { return __builtin_amdgcn_fdot2_f32_bf16(__builtin_bit_cast(bf16x2_t, a), __builtin_bit_cast(bf16x2_t, b), c, false); }
DI bf16x8 pack8(float a0, float a1, float a2, float a3, float a4, float a5, float a6, float a7) { v4u p; p.x = pk2(a0, a1); p.y = pk2(a2, a3); p.z = pk2(a4, a5); p.w = pk2(a6, a7); return __builtin_bit_cast(bf16x8, p); }
DI float wave_sum(float v) {
#pragma unroll
    for (int o = 1; o < 64; o <<= 1) v += __shfl_xor(v, o);
    return v;
}

template <int CTRL> DI float dpp_f2(float v) { return __uint_as_float((unsigned)__builtin_amdgcn_update_dpp(0, (int)__float_as_uint(v), CTRL, 0xF, 0xF, false)); }
#define XB_TMO      128
#define XB_XCNT(j)  (256  + 64 * (j))
#define XB_XSUB(j)  (1280 + 64 * (j))
#define XB_XGEN(j)  (2304 + 64 * (j))
#define XB_TOP      3328
#define XB_TOPGEN   3392
#define XCD_BAR_WORDS 3456
#define XB_SPIN_CAP (1u << 18)
DI unsigned xb_ld(unsigned* p)              { return __hip_atomic_load(p, __ATOMIC_RELAXED, __HIP_MEMORY_SCOPE_AGENT); }
DI unsigned xb_add(unsigned* p, unsigned v) { return __hip_atomic_fetch_add(p, v, __ATOMIC_RELAXED, __HIP_MEMORY_SCOPE_AGENT); }
DI unsigned xb_xcc_id() { return (unsigned)__builtin_amdgcn_s_getreg((3 << 11) | 20) & 0xFu; }
#define XB_SPIN(cond, bar) do { unsigned _sp = 0; while (cond) { __builtin_amdgcn_s_sleep(1); \
    if ((++_sp & 255u) == 0u) { if (xb_ld(&(bar)[XB_TMO])) break; if (_sp > XB_SPIN_CAP) { atomicAdd(&(bar)[XB_TMO], 1u); break; } } } } while (0)
struct XcdBarrier { unsigned* bar; unsigned x; volatile LAS unsigned* st; };
DI XcdBarrier xcd_barrier_post(unsigned* bar, volatile LAS unsigned* st) {
    XcdBarrier b; b.bar = bar; b.x = xb_xcc_id(); b.st = st;
    if (threadIdx.x == 0) (void)xb_add(&bar[XB_XCNT(b.x)], 1u);
    return b;
}
DI void xcd_barrier_complete(unsigned* bar, unsigned x, unsigned& nloc, unsigned& nx) {
    const unsigned G = gridDim.x * gridDim.y * gridDim.z;
    unsigned sum, cnt, mine, sp = 0u;
    for (;;) {
        sum = 0u; cnt = 0u; mine = 0u;
#pragma unroll
        for (unsigned j = 0; j < 16; ++j) { const unsigned c = xb_ld(&bar[XB_XCNT(j)]); sum += c; cnt += (c > 0u) ? 1u : 0u; mine = (j == x) ? c : mine; }
        if (sum == G) break;
        __builtin_amdgcn_s_sleep(1);
        if ((++sp & 255u) == 0u) { if (xb_ld(&bar[XB_TMO])) break; if (sp > XB_SPIN_CAP) { atomicAdd(&bar[XB_TMO], 1u); break; } }
    }
    nloc = mine > 0u ? mine : 1u; nx = cnt > 0u ? cnt : 1u;
}
DI void xcd_barrier(const XcdBarrier& b) {
    asm volatile("s_waitcnt vmcnt(0)" ::: "memory");
    __syncthreads();
    if (threadIdx.x == 0) {
        unsigned* bar = b.bar;
        __builtin_amdgcn_s_waitcnt(0);
        unsigned nloc = b.st[0], nx = b.st[1];
        if (nloc == 0u) { xcd_barrier_complete(bar, b.x, nloc, nx); b.st[0] = nloc; b.st[1] = nx; }
        const unsigned old = xb_add(&bar[XB_XSUB(b.x)], 1u);
        const unsigned gen = old / nloc;
        if (old + 1u == (gen + 1u) * nloc) {
            __builtin_amdgcn_fence(__ATOMIC_RELEASE, "agent");
            asm volatile("s_waitcnt vmcnt(0)" ::: "memory");
            const unsigned og = xb_add(&bar[XB_TOP], 1u);
            const unsigned tg = og / nx;
            if (og + 1u == (tg + 1u) * nx) xb_add(&bar[XB_TOPGEN], 1u);
            else XB_SPIN(xb_ld(&bar[XB_TOPGEN]) == tg, bar);
            __builtin_amdgcn_fence(__ATOMIC_ACQUIRE, "agent");
            xb_add(&bar[XB_XGEN(b.x)], 1u);
            asm volatile("s_waitcnt vmcnt(0)" ::: "memory");
        } else {
            XB_SPIN(xb_ld(&bar[XB_XGEN(b.x)]) == gen, bar);
            __builtin_amdgcn_fence(__ATOMIC_ACQUIRE, "agent");
            asm volatile("s_waitcnt vmcnt(0)" ::: "memory");
        }
    }
    __syncthreads();
}

struct Frame {
    LAS unsigned char* lds;
    volatile LAS unsigned* MISC;
    gu32* ctl;
    int tid, lane, wave;
    int vcu, G;
    const float *x, *mix_g, *w_in, *q_g, *k_g, *sgu_vg, *sgu_w, *sgu_b, *sb_og, *sgu_og, *w_out, *ffn_g, *w_q, *keys, *pu, *pv;
    float* out;
    unsigned char *XN, *WA, *WB, *MIXQ, *WO;
    float *SA, *SWA, *SWB, *SA2, *SWO;
    bf16 *WS, *QKU, *VG, *MIX, *HB;
    unsigned char *UT, *VT;
    float *GVP, *HSS, *SC, *USC, *VSC;
};

DI void rms_row_to_i8(const float* xrow, const f32x4 (&gr)[16], unsigned char* orow, float* scale, int lane) {
    const GAS f32x4* xr = (const GAS f32x4*)xrow + lane;
    f32x4 v[16]; float s = 0.f;
#pragma unroll
    for (int j = 0; j < 16; ++j) { v[j] = __builtin_nontemporal_load(xr + 64 * j); s += (v[j].x * v[j].x + v[j].y * v[j].y) + (v[j].z * v[j].z + v[j].w * v[j].w); }
    const float rstd = __builtin_amdgcn_rsqf(wave_sum(s) * (1.f / DM) + EPS);
    float m = 0.f;
#pragma unroll
    for (int j = 0; j < 16; ++j) { v[j] = v[j] * gr[j] * rstd;
        m = __builtin_fmaxf(__builtin_fmaxf(m, __builtin_fmaxf(__builtin_fabsf(v[j].x), __builtin_fabsf(v[j].y))), __builtin_fmaxf(__builtin_fabsf(v[j].z), __builtin_fabsf(v[j].w))); }
#pragma unroll
    for (int o = 1; o < 64; o <<= 1) m = __builtin_fmaxf(m, __shfl_xor(m, o));
    const float inv = m > 0.f ? 127.0f / m : 0.f;
    GAS unsigned* o4 = (GAS unsigned*)orow + lane;
#pragma unroll
    for (int j = 0; j < 16; ++j) { const int q0 = (int)__builtin_rintf(v[j].x * inv), q1 = (int)__builtin_rintf(v[j].y * inv), q2 = (int)__builtin_rintf(v[j].z * inv), q3 = (int)__builtin_rintf(v[j].w * inv);
        o4[64 * j] = (unsigned)(q0 & 255) | ((unsigned)(q1 & 255) << 8) | ((unsigned)(q2 & 255) << 16) | ((unsigned)(q3 & 255) << 24); }
    if (lane == 0) *scale = m * (1.0f / 127.0f);
}
DI void p0_strip(Frame& F, const float* W, int N, int n0, unsigned char* dst_row0, float* scale_row0, LAS unsigned char* wl  , LAS float* xm  ) {
    const int lane = F.lane, c = lane & 31, p = lane >> 5, w = F.wave;
    const float* src = W + (size_t)(512 * w + p) * N + n0 + c;
    const size_t rstep = (size_t)2 * N;
    unsigned pk[128]; float m = 0.f;
    float t[2][32];
#pragma unroll
    for (int j = 0; j < 32; ++j) { t[0][j] = __builtin_nontemporal_load(src); src += rstep; }
#pragma unroll
    for (int b = 0; b < 8; ++b) {
        if (b < 7) {
#pragma unroll
            for (int j = 0; j < 32; ++j) { t[(b + 1) & 1][j] = __builtin_nontemporal_load(src); src += rstep; } }
#pragma unroll
        for (int j = 0; j < 32; j += 2) { const float a = t[b & 1][j], c = t[b & 1][j + 1];
            m = __builtin_fmaxf(m, __builtin_fmaxf(__builtin_fabsf(a), __builtin_fabsf(c))); pk[(32 * b + j) >> 1] = pk2(a, c); asm volatile("" : "+v"(pk[(32 * b + j) >> 1])); }
        asm volatile("" ::: "memory"); }
    { auto rr = __builtin_amdgcn_permlane32_swap(__float_as_uint(m), __float_as_uint(m), false, false); m = __builtin_fmaxf(__uint_as_float(rr[0]), __uint_as_float(rr[1])); }
    if (lane < 32) xm[w * 32 + c] = m;
    __syncthreads();
    float cm = 0.f;
#pragma unroll
    for (int ww = 0; ww < 8; ++ww) cm = __builtin_fmaxf(cm, xm[ww * 32 + c]);
    const float inv = cm > 0.f ? 127.0f / cm : 0.f;
    if (w == 0 && lane < 32) scale_row0[c] = cm * (1.0f / 127.0f);
    unsigned d[64];
#pragma unroll
    for (int j = 0; j < 64; ++j) { const unsigned a = pk[2 * j], b = pk[2 * j + 1];
        const int q0 = (int)__builtin_rintf(bflo(a) * inv), q1 = (int)__builtin_rintf(bfhi(a) * inv), q2 = (int)__builtin_rintf(bflo(b) * inv), q3 = (int)__builtin_rintf(bfhi(b) * inv);
        d[j] = (unsigned)(q0 & 255) | ((unsigned)(q1 & 255) << 8) | ((unsigned)(q2 & 255) << 16) | ((unsigned)(q3 & 255) << 24); asm volatile("" : "+v"(d[j])); }
    LAS unsigned char* myrow = wl + c * 528 + 256 * p;
#pragma unroll
    for (int tq = 0; tq < 16; ++tq) { v4u o;
        { auto rr = __builtin_amdgcn_permlane32_swap(d[2 * tq], d[2 * tq + 32], false, false); const unsigned E = rr[0], O = rr[1];
          o.x = __builtin_amdgcn_perm(O, E, 0x05010400u); o.y = __builtin_amdgcn_perm(O, E, 0x07030602u); }
        { auto rr = __builtin_amdgcn_permlane32_swap(d[2 * tq + 1], d[2 * tq + 33], false, false); const unsigned E = rr[0], O = rr[1];
          o.z = __builtin_amdgcn_perm(O, E, 0x05010400u); o.w = __builtin_amdgcn_perm(O, E, 0x07030602u); }
        *(LAS v4u*)(myrow + 16 * tq) = o; }
    asm volatile("s_waitcnt lgkmcnt(0)" ::: "memory");
#pragma unroll
    for (int i = 0; i < 16; ++i) { const int row = 2 * i + p; const v4u v = *(const LAS v4u*)(wl + row * 528 + 16 * c);
        *(GAS v4u*)(dst_row0 + (size_t)row * DM + 512 * w + 16 * c) = v; }
    __syncthreads();
}
DI void p0_ws_unit(Frame& F, int unit) {
    const int hp = unit >> 4, grp = unit & 15, lane = F.lane, r = lane & 31, h = lane >> 5;
    LAS unsigned char* kl = F.lds + RING_OFF;
    __syncthreads();
    { f32x4 kb0[8], kb1[8];
#pragma unroll
      for (int i = 0; i < 8; ++i) { const int f = F.wave + NWAVES * i, nb = f >> 4, sft = f & 15;
          const float* bp = F.keys + ((size_t)hp * 128 + nb * 32 + r) * 256 + 16 * sft + 8 * h;
          kb0[i] = *(const f32x4*)bp; kb1[i] = *(const f32x4*)(bp + 4); }
#pragma unroll
      for (int i = 0; i < 8; ++i) { const int f = F.wave + NWAVES * i;
          *(LAS bf16x8*)(kl + f * 1024 + lane * 16) = pack8(kb0[i].x, kb0[i].y, kb0[i].z, kb0[i].w, kb1[i].x, kb1[i].y, kb1[i].z, kb1[i].w); } }
    __syncthreads();
    const int dblk = grp * 8 + F.wave;
    const float* ap = F.w_q + (size_t)(dblk * 32 + r) * DM + hp * 256 + 8 * h;
    f32x16 d[4];
#pragma unroll
    for (int nb = 0; nb < 4; ++nb)
#pragma unroll
        for (int i = 0; i < 16; ++i) d[nb][i] = 0.f;
    f32x4 av[16][2];
#pragma unroll
    for (int sft = 0; sft < 16; ++sft) { av[sft][0] = *(const f32x4*)(ap + 16 * sft); av[sft][1] = *(const f32x4*)(ap + 16 * sft + 4); }
#pragma unroll
    for (int sft = 0; sft < 16; ++sft) {
        const bf16x8 af = pack8(av[sft][0].x, av[sft][0].y, av[sft][0].z, av[sft][0].w, av[sft][1].x, av[sft][1].y, av[sft][1].z, av[sft][1].w);
#pragma unroll
        for (int nb = 0; nb < 4; ++nb) d[nb] = MFMA32(af, *(const LAS bf16x8*)(kl + (nb * 16 + sft) * 1024 + lane * 16), d[nb]);
    }
#pragma unroll
    for (int m = 0; m < 4; ++m) { const int dd = dblk * 32 + 8 * m + 4 * h; const f32x4 g = *(const f32x4*)(F.ffn_g + dd);
#pragma unroll
        for (int nb = 0; nb < 4; ++nb) { v2u o; o.x = pk2(d[nb][4 * m] * g.x, d[nb][4 * m + 1] * g.y); o.y = pk2(d[nb][4 * m + 2] * g.z, d[nb][4 * m + 3] * g.w);
            *(GAS v2u*)(F.WS + (size_t)(hp * 128 + nb * 32 + r) * DM + dd) = o; } }
}
DI void p0_prologue(Frame& F) {
    const int gw = F.vcu * NWAVES + F.wave, NGW = F.G * NWAVES;
    { f32x4 gr[16];
#pragma unroll
      for (int j = 0; j < 16; ++j) gr[j] = ((const GAS f32x4*)F.mix_g)[F.lane + 64 * j];
      for (int m = gw; m < T; m += NGW) rms_row_to_i8(F.x + (size_t)m * DM, gr, F.XN + (size_t)m * DM, F.SA + m, F.lane); }
    { constexpr int NIN = 10240, S_IN = NIN / 32, S_O = DM / 32; LAS float* xm = (LAS float*)(F.lds + P5_LIST_OFF);
      __syncthreads();
      for (int u = F.vcu; u < S_IN + S_O; u += F.G) {
          if (u < S_IN) { const int n0 = 32 * u, seg = n0 >> 11, within = n0 & 2047;
              const int drow = (seg == 0 || seg == 1) ? n0 : (seg == 2) ? within : (seg == 3) ? 4096 + within : 2048 + within; const bool toa = (seg == 0 || seg == 1 || seg == 3);
              p0_strip(F, F.w_in, NIN, n0, (toa ? F.WA : F.WB) + (size_t)drow * DM, (toa ? F.SWA : F.SWB) + drow, F.lds + F.wave * 18432, xm);
          } else { const int n0 = 32 * (u - S_IN);
              p0_strip(F, F.w_out, DM, n0, F.WO + (size_t)n0 * DM, F.SWO + n0, F.lds + F.wave * 18432, xm); } } }
    for (int unit = F.vcu; unit < 256; unit += F.G) p0_ws_unit(F, unit);
    __syncthreads();
}

template <int CTRL> DI unsigned dpp_u(unsigned v) { return (unsigned)__builtin_amdgcn_update_dpp(0, (int)v, CTRL, 0xF, 0xF, false); }
template <int CTRL> DI float dpp_f(float v) { return __uint_as_float(dpp_u<CTRL>(__float_as_uint(v))); }
DI unsigned umax(unsigned a, unsigned b) { return a > b ? a : b; }
DI unsigned umin(unsigned a, unsigned b) { return a < b ? a : b; }
DI unsigned row_umax(unsigned v) { v = umax(v, dpp_u<0xB1>(v)); v = umax(v, dpp_u<0x4E>(v)); v = umax(v, dpp_u<0x124>(v)); v = umax(v, dpp_u<0x128>(v)); return v; }
DI float row_fsum(float v) { v += dpp_f<0xB1>(v); v += dpp_f<0x4E>(v); v += dpp_f<0x124>(v); v += dpp_f<0x128>(v); return v; }
DI float rl_f(float v, int l) { return __uint_as_float((unsigned)__builtin_amdgcn_readlane((int)__float_as_uint(v), l)); }
DI float wave_fmax_u(float v) { v = __builtin_fmaxf(v, dpp_f<0xB1>(v)); v = __builtin_fmaxf(v, dpp_f<0x4E>(v)); v = __builtin_fmaxf(v, dpp_f<0x124>(v)); v = __builtin_fmaxf(v, dpp_f<0x128>(v));
    return __builtin_fmaxf(__builtin_fmaxf(rl_f(v, 0), rl_f(v, 16)), __builtin_fmaxf(rl_f(v, 32), rl_f(v, 48))); }
DI float wave_fsum_u(float v) { v = row_fsum(v); return (rl_f(v, 0) + rl_f(v, 16)) + (rl_f(v, 32) + rl_f(v, 48)); }
DI float xor16_f(float v) { return __uint_as_float((unsigned)__builtin_amdgcn_ds_swizzle((int)__float_as_uint(v), 0x401F)); }
DI void tq_load(const Frame& F, int row, int lane, f32x4 (&v)[16]) {
    const bool isv = row >= NEXP; const int e = isv ? row - NEXP : row;
    const GAS f32x4* src = (const GAS f32x4*)((isv ? F.pv : F.pu) + (size_t)e * DM) + lane;
#pragma unroll
    for (int j = 0; j < 16; ++j) v[j] = __builtin_nontemporal_load(src + 64 * j);
}
DI void tq_store(const Frame& F, int row, int lane, const f32x4 (&v)[16]) {
    const bool isv = row >= NEXP; const int e = isv ? row - NEXP : row;
    float ss = 0.f;
#pragma unroll
    for (int j = 0; j < 16; ++j) ss += (v[j].x * v[j].x + v[j].y * v[j].y) + (v[j].z * v[j].z + v[j].w * v[j].w);
    ss = wave_fsum_u(ss);
    const float step = 0.35f * __builtin_sqrtf(ss * (1.0f / DM)); const float inv = step > 0.f ? 1.0f / step : 0.f;
    constexpr float MAGIC = 12582912.0f + 8.0f; constexpr unsigned MBITS = 0x4B400000u, KSUB = MBITS * 0x11111111u;
    const unsigned flip = isv ? 0x80808080u : 0x88888888u;
    unsigned dw[8];
#pragma unroll
    for (int j = 0; j < 8; ++j) { unsigned w = 0u;
#pragma unroll
        for (int n = 0; n < 8; ++n) { const float x = v[2 * j + (n >> 2)][n & 3];
            const int sh = isv ? 4 * n : 4 * (n < 4 ? 2 * n : 2 * (n - 4) + 1);
            const float y = __builtin_amdgcn_fmed3f(__builtin_fmaf(x, inv, MAGIC), MAGIC - 7.0f, MAGIC + 7.0f); w += __float_as_uint(y) << sh; }
        dw[j] = (w - KSUB) ^ flip; }
    unsigned char* rowp = (isv ? F.VT : F.UT) + (size_t)e * TROW; GAS v4u* dst = (GAS v4u*)rowp + lane;
    v4u o0; o0.x = dw[0]; o0.y = dw[1]; o0.z = dw[2]; o0.w = dw[3]; v4u o1; o1.x = dw[4]; o1.y = dw[5]; o1.z = dw[6]; o1.w = dw[7];
    dst[0] = o0; dst[64] = o1;
    if (lane == 0) (isv ? F.VSC : F.USC)[e] = step;
}

DI void attn_dma_k(const unsigned char* tile  , LAS unsigned char* kbuf, unsigned koff) {
    asm volatile("" : "+v"(koff));
#pragma unroll
    for (int i = 0; i < 8; ++i)
        __builtin_amdgcn_global_load_lds((const unsigned*)(tile + (size_t)i * (4 * SBW * 2) + (koff ^ (64u * (i & 3)))), (LAS unsigned*)(kbuf + i * 1024), 16, 0, 0);
}
DI void attn_dma_v(const unsigned char* tile  , LAS unsigned char* vbuf, unsigned voff) {
    asm volatile("" : "+v"(voff));
#pragma unroll
    for (int i = 0; i < 8; ++i)
        __builtin_amdgcn_global_load_lds((const unsigned*)(tile + (size_t)i * (16 * T * 2) + voff), (LAS unsigned*)(vbuf + i * 1024), 16, 0, 0);
}
DI void stash_put(LAS unsigned char* st, int r, int h, int blk, int m, v2u p) { *(LAS v2u*)(st + r * 256 + (((4 * blk + m) ^ (r & 15)) << 4) + 8 * h) = p; }
DI void stash_store(const LAS unsigned char* st, bf16* gtile  , int ld, int lane, const float* gain  , float (&mx)[8]) {
    asm volatile("s_waitcnt lgkmcnt(0)" ::: "memory");
    const int c = lane & 15; const f32x4 g0 = *(const f32x4*)(gain + 8 * c), g1 = *(const f32x4*)(gain + 8 * c + 4);
#pragma unroll
    for (int i = 0; i < 8; ++i) { const int row = 4 * i + (lane >> 4);
        const v4u v = *(const LAS v4u*)(st + row * 256 + ((c ^ (row & 15)) << 4));
        *(GAS v4u*)(gtile + (size_t)row * ld + 8 * c) = v;
        float m = __builtin_fmaxf(__builtin_fmaxf(__builtin_fabsf(bflo(v.x) * g0.x), __builtin_fabsf(bfhi(v.x) * g0.y)), __builtin_fmaxf(__builtin_fabsf(bflo(v.y) * g0.z), __builtin_fabsf(bfhi(v.y) * g0.w)));
        m = __builtin_fmaxf(m, __builtin_fmaxf(__builtin_fmaxf(__builtin_fabsf(bflo(v.z) * g1.x), __builtin_fabsf(bfhi(v.z) * g1.y)), __builtin_fmaxf(__builtin_fabsf(bflo(v.w) * g1.z), __builtin_fabsf(bfhi(v.w) * g1.w))));
        mx[i] = __builtin_fmaxf(mx[i], m); }
}
DI void attn_head(Frame& F, int hd, int q0, LAS float* scr, const LAS float* gqk, LAS unsigned char* wl, float& ssq, float (&mx)[8]) {
    const int lane = F.lane, r = lane & 31, h = lane >> 5;
    const bf16* qraw = F.QKU; const bf16* kraw = F.QKU + (size_t)T * SBW; const bf16* vT = F.VG;
    LAS unsigned char* kbuf = wl; LAS unsigned char* vbuf = wl + 8192;
    const unsigned koff = (unsigned)((lane >> 4) * (SBW * 2) + 16 * ((lane & 15) ^ (lane >> 4)));
    const unsigned voff = (unsigned)((lane >> 2) * (T * 2) + 16 * ((lane & 3) ^ ((lane >> 4) & 3)));
    const unsigned char* kcol = (const unsigned char*)(kraw + hd * HD); const unsigned char* vrow = (const unsigned char*)(vT + (size_t)(hd * HD) * T);
    bf16x8 qf[8];
    { const bf16* qp = qraw + (size_t)(q0 + r) * SBW + hd * HD + 8 * h;
      v4u raw[8]; float ss = 0.f;
#pragma unroll
      for (int s = 0; s < 8; ++s) raw[s] = *(const GAS v4u*)(qp + 16 * s);
      asm volatile("" ::: "memory");
      attn_dma_k(kcol + (size_t)q0 * (SBW * 2), kbuf, koff); attn_dma_v(vrow + (size_t)q0 * 2, vbuf, voff);
#pragma unroll
      for (int s = 0; s < 8; ++s)
#pragma unroll
          for (int w = 0; w < 4; ++w) ss = dot2bf(raw[s][w], raw[s][w], ss);
      ss = swap_add(ss);
      const float rq = __builtin_amdgcn_rsqf(ss * (1.f / HD) + EPS);
#pragma unroll
      for (int s = 0; s < 8; ++s) { const int d0 = 16 * s + 8 * h;
          const f32x4 a0 = *(const LAS f32x4*)(gqk + d0), a1 = *(const LAS f32x4*)(gqk + d0 + 4);
          qf[s] = pack8(bflo(raw[s][0]) * rq * a0.x, bfhi(raw[s][0]) * rq * a0.y, bflo(raw[s][1]) * rq * a0.z, bfhi(raw[s][1]) * rq * a0.w,
                        bflo(raw[s][2]) * rq * a1.x, bfhi(raw[s][2]) * rq * a1.y, bflo(raw[s][3]) * rq * a1.z, bfhi(raw[s][3]) * rq * a1.w); }
    }
    f32x16 o[4];
#pragma unroll
    for (int db = 0; db < 4; ++db)
#pragma unroll
        for (int i = 0; i < 16; ++i) o[db][i] = 0.f;
    float cdec = 0.f;
    const unsigned kfa = (unsigned)(uintptr_t)kbuf + r * 256 + ((h ^ (r & 15)) << 4);
    unsigned vfa[4];
#pragma unroll
    for (int cc = 0; cc < 4; ++cc) vfa[cc] = (unsigned)(uintptr_t)vbuf + r * 64 + 8 * h + ((cc ^ ((r >> 2) & 3)) << 4);
    for (int kt = q0;; kt -= 32) {
        const bool diag = (kt == q0);
        const int ktn = kt >= 32 ? kt - 32 : 0;
        asm volatile("s_waitcnt vmcnt(8)" ::: "memory");
        v4u kr[8];
        { unsigned ka = kfa; asm volatile("" : "+v"(ka));
#pragma unroll
          for (int s = 0; s < 8; ++s) kr[s] = *(const LAS v4u*)(uintptr_t)(ka ^ (unsigned)(s << 5)); }
        asm volatile("s_waitcnt lgkmcnt(0)" ::: "memory");
        attn_dma_k(kcol + (size_t)ktn * (SBW * 2), kbuf, koff);
        float ks = 0.f;
#pragma unroll
        for (int s = 0; s < 8; ++s)
#pragma unroll
            for (int w = 0; w < 4; ++w) ks = dot2bf(kr[s][w], kr[s][w], ks);
        ks = swap_add(ks);
        const float rkl = __builtin_amdgcn_rsqf(ks * (1.f / HD) + EPS);
        f32x16 st;
#pragma unroll
        for (int i = 0; i < 16; ++i) st[i] = 0.f;
#pragma unroll
        for (int s = 0; s < 8; ++s) st = MFMA32(__builtin_bit_cast(bf16x8, kr[s]), qf[s], st);
        if (h == 0) scr[r] = rkl;
        f32x4 rk4[4];
#pragma unroll
        for (int m = 0; m < 4; ++m) rk4[m] = *(const LAS f32x4*)(scr + 8 * m + 4 * h);
        float z[16], sp[16];
#pragma unroll
        for (int i = 0; i < 16; ++i) { z[i] = st[i] * rk4[i >> 2][i & 3]; const float e = __builtin_amdgcn_exp2f(-__builtin_fabsf(z[i])); sp[i] = __builtin_fmaxf(z[i], 0.f) + __builtin_amdgcn_logf(1.0f + e); }
        if (diag) {
#pragma unroll
            for (int i = 0; i < 16; ++i) if (!(crow(i, h) < r)) sp[i] = 0.f; }
        float G[8];
#pragma unroll
        for (int m = 0; m < 4; ++m) { const float sm = (sp[4 * m] + sp[4 * m + 1]) + (sp[4 * m + 2] + sp[4 * m + 3]);
            auto rr = __builtin_amdgcn_permlane32_swap(__float_as_uint(sm), __float_as_uint(sm), false, false); G[2 * m] = __uint_as_float(rr[0]); G[2 * m + 1] = __uint_as_float(rr[1]); }
        float Tg[8]; Tg[7] = 0.f;
#pragma unroll
        for (int g = 6; g >= 0; --g) Tg[g] = Tg[g + 1] + G[g + 1];
        const float total = Tg[0] + G[0];
        float a[16];
#pragma unroll
        for (int m = 0; m < 4; ++m) { const float s3 = cdec + (h ? Tg[2 * m + 1] : Tg[2 * m]); const float s2 = s3 + sp[4 * m + 3], s1 = s2 + sp[4 * m + 2], s0 = s1 + sp[4 * m + 1];
            a[4 * m + 3] = __builtin_amdgcn_exp2f(z[4 * m + 3] - sp[4 * m + 3] - s3); a[4 * m + 2] = __builtin_amdgcn_exp2f(z[4 * m + 2] - sp[4 * m + 2] - s2);
            a[4 * m + 1] = __builtin_amdgcn_exp2f(z[4 * m + 1] - sp[4 * m + 1] - s1); a[4 * m] = __builtin_amdgcn_exp2f(z[4 * m] - sp[4 * m] - s0); }
        if (diag) {
#pragma unroll
            for (int i = 0; i < 16; ++i) if (!(crow(i, h) < r)) a[i] = 0.f; }
        cdec += total;
        const bf16x8 af0 = pack8(a[0], a[1], a[2], a[3], a[4], a[5], a[6], a[7]), af1 = pack8(a[8], a[9], a[10], a[11], a[12], a[13], a[14], a[15]);
        asm volatile("s_waitcnt vmcnt(8)" ::: "memory");
        v2u vlo[4][2], vhi[4][2];
#pragma unroll
        for (int db = 0; db < 4; ++db)
#pragma unroll
            for (int s2 = 0; s2 < 2; ++s2) { vlo[db][s2] = *(const LAS v2u*)(uintptr_t)(vfa[2 * s2] + db * 2048); vhi[db][s2] = *(const LAS v2u*)(uintptr_t)(vfa[2 * s2 + 1] + db * 2048); }
        asm volatile("s_waitcnt lgkmcnt(0)" ::: "memory");
        attn_dma_v(vrow + (size_t)ktn * 2, vbuf, voff);
#pragma unroll
        for (int db = 0; db < 4; ++db) {
            v4u v0; v0.x = vlo[db][0].x; v0.y = vlo[db][0].y; v0.z = vhi[db][0].x; v0.w = vhi[db][0].y;
            v4u v1; v1.x = vlo[db][1].x; v1.y = vlo[db][1].y; v1.z = vhi[db][1].x; v1.w = vhi[db][1].y;
            o[db] = MFMA32(__builtin_bit_cast(bf16x8, v0), af0, o[db]); o[db] = MFMA32(__builtin_bit_cast(bf16x8, v1), af1, o[db]); }
        if (kt == 0 || __all(cdec > ATT_EXIT)) break;
    }
    asm volatile("s_waitcnt vmcnt(0)" ::: "memory");
    float ss = 0.f;
#pragma unroll
    for (int db = 0; db < 4; ++db)
#pragma unroll
        for (int i = 0; i < 16; ++i) ss += o[db][i] * o[db][i];
    ssq += swap_add(ss);
#pragma unroll
    for (int db = 0; db < 4; ++db)
#pragma unroll
        for (int m = 0; m < 4; ++m) { v2u p; p.x = pk2(o[db][4 * m], o[db][4 * m + 1]); p.y = pk2(o[db][4 * m + 2], o[db][4 * m + 3]); stash_put(kbuf, r, h, db, m, p); }
    stash_store(kbuf, F.MIX + (size_t)q0 * DM + hd * HD, DM, lane, F.sb_og + hd * HD, mx);
}
DI void sgu_group(Frame& F, int g, int n, int rq, LAS float* scr, LAS unsigned char* wl, float& ssq, float (&mx)[8]) {
    const int lane = F.lane, r = lane & 31, h = lane >> 5;
    const bf16* gvT = F.VG + (size_t)SBW * T;
    const bf16* ub = F.QKU + (size_t)2 * T * SBW;
    const int tl = 32 * rq + r;
    const int nks = 2 * (rq + 1);
    unsigned goff = (unsigned)((lane >> 4) * (T * 2) + 16 * ((lane & 15) ^ (lane >> 4)));
    const unsigned char* gtile = (const unsigned char*)(gvT + (size_t)(g * 128) * T + 128 * n);
    auto dma_half = [&](int half) {
        asm volatile("" : "+v"(goff));
#pragma unroll
        for (int i = 0; i < 16; ++i)
            __builtin_amdgcn_global_load_lds((const unsigned*)(gtile + (size_t)(half * 64 + 4 * i) * (T * 2) + (goff ^ (64u * (i & 3)))), (LAS unsigned*)(wl + i * 1024), 16, 0, 0); };
    float gp[2][2];
#pragma unroll
    for (int i = 0; i < 2; ++i) { const int s = lane + 64 * i; gp[i][0] = F.GVP[(size_t)g * T + 128 * n + s]; gp[i][1] = F.GVP[(size_t)(16 + g) * T + 128 * n + s]; }
    const float* wrow = F.sgu_w + ((size_t)g * 128 + tl) * 128 + 8 * h;
    f32x4 w0[8], w1[8];
#pragma unroll
    for (int ks = 0; ks < 8; ++ks) if (ks < nks) { w0[ks] = *(const f32x4*)(wrow + 16 * ks); w1[ks] = *(const f32x4*)(wrow + 16 * ks + 4); }
    asm volatile("" ::: "memory");
    dma_half(0);
#pragma unroll
    for (int i = 0; i < 2; ++i) scr[lane + 64 * i] = __builtin_amdgcn_rsqf((gp[i][0] + gp[i][1]) * (1.f / 128.f) + EPS);
    bf16x8 wf[8];
    {
#pragma unroll
      for (int ks = 0; ks < 8; ++ks) if (ks < nks) {
          const f32x4 r0 = *(const LAS f32x4*)(scr + 16 * ks + 8 * h), r1 = *(const LAS f32x4*)(scr + 16 * ks + 8 * h + 4);
          const int s0 = 16 * ks + 8 * h;
          float wv[8] = {w0[ks].x * r0.x, w0[ks].y * r0.y, w0[ks].z * r0.z, w0[ks].w * r0.w, w1[ks].x * r1.x, w1[ks].y * r1.y, w1[ks].z * r1.z, w1[ks].w * r1.w};
#pragma unroll
          for (int j = 0; j < 8; ++j) if (s0 + j > tl) wv[j] = 0.f;
          wf[ks] = pack8(wv[0], wv[1], wv[2], wv[3], wv[4], wv[5], wv[6], wv[7]); } }
    f32x16 d[4];
#pragma unroll
    for (int cb = 0; cb < 4; ++cb)
#pragma unroll
        for (int i = 0; i < 16; ++i) d[cb][i] = 0.f;
#pragma unroll
    for (int half = 0; half < 2; ++half) {
        asm volatile("s_waitcnt vmcnt(0)" ::: "memory");
#pragma unroll
        for (int cbl = 0; cbl < 2; ++cbl) { unsigned aa = (unsigned)(uintptr_t)wl + (cbl * 32 + r) * 256 + ((h ^ (r & 15)) << 4); asm volatile("" : "+v"(aa));
#pragma unroll
            for (int ks = 0; ks < 8; ++ks) if (ks < nks) { const v4u av = *(const LAS v4u*)(uintptr_t)(aa ^ (unsigned)(ks << 5));
                d[2 * half + cbl] = MFMA32(__builtin_bit_cast(bf16x8, av), wf[ks], d[2 * half + cbl]); } }
        if (half == 0) { asm volatile("s_waitcnt lgkmcnt(0)" ::: "memory"); dma_half(1); }
    }
    const float bias = F.sgu_b[g * 128 + tl];
    f32x4 gg[4][4];
#pragma unroll
    for (int cb = 0; cb < 4; ++cb)
#pragma unroll
        for (int m = 0; m < 4; ++m) gg[cb][m] = *(const f32x4*)(F.sgu_vg + g * 128 + cb * 32 + 8 * m + 4 * h);
    asm volatile("s_waitcnt lgkmcnt(0)" ::: "memory");
    { const unsigned uoff = (unsigned)((lane >> 4) * (SBW * 2) + 16 * ((lane & 15) ^ (lane >> 4)));
      attn_dma_k((const unsigned char*)(ub + (size_t)(128 * n + 32 * rq) * SBW + g * 128), wl, uoff); }
    asm volatile("s_waitcnt vmcnt(0)" ::: "memory");
    LAS unsigned char* st = wl + 8192;
    float ss = 0.f;
#pragma unroll
    for (int cb = 0; cb < 4; ++cb)
#pragma unroll
        for (int m = 0; m < 4; ++m) {
            const v2u uu = *(const LAS v2u*)(wl + r * 256 + (((4 * cb + m) ^ (r & 15)) << 4) + 8 * h);
            const float o0 = bflo(uu.x) * (d[cb][4 * m] * gg[cb][m].x + bias), o1 = bfhi(uu.x) * (d[cb][4 * m + 1] * gg[cb][m].y + bias), o2 = bflo(uu.y) * (d[cb][4 * m + 2] * gg[cb][m].z + bias), o3 = bfhi(uu.y) * (d[cb][4 * m + 3] * gg[cb][m].w + bias);
            ss += (o0 * o0 + o1 * o1) + (o2 * o2 + o3 * o3);
            v2u p; p.x = pk2(o0, o1); p.y = pk2(o2, o3); stash_put(st, r, h, cb, m, p); }
    ssq += swap_add(ss);
    stash_store(st, F.MIX + (size_t)(128 * n + 32 * rq) * DM + SBW + g * 128, DM, lane, F.sgu_og + g * 128, mx);
}
DI float row_fmax(float v) { v = __builtin_fmaxf(v, dpp_f2<0xB1>(v)); v = __builtin_fmaxf(v, dpp_f2<0x4E>(v)); v = __builtin_fmaxf(v, dpp_f2<0x124>(v)); v = __builtin_fmaxf(v, dpp_f2<0x128>(v)); return v; }
DI void renorm_q8(Frame& F, int q0, const LAS float* fA, const LAS float* fS, int w, int lane) {
    const int c = lane & 15, rl = lane >> 4;
    float fa[8], fs[8];
#pragma unroll
    for (int i = 0; i < 8; ++i) { fa[i] = fA[4 * i + rl]; fs[i] = fS[4 * i + rl]; }
#pragma unroll 1
    for (int tt = 0; tt < 4; ++tt) { const int colt = (tt < 2 ? 0 : SBW) + (2 * w + (tt & 1)) * 128; const float* gn = (tt < 2 ? F.sb_og : F.sgu_og) + (2 * w + (tt & 1)) * 128;
        const f32x4 g0 = *(const f32x4*)(gn + 8 * c), g1 = *(const f32x4*)(gn + 8 * c + 4); v4u q[8];
#pragma unroll
        for (int i = 0; i < 8; ++i) q[i] = *(const GAS v4u*)(F.MIX + (size_t)(q0 + 4 * i + rl) * DM + colt + 8 * c);
#pragma unroll
        for (int i = 0; i < 8; ++i) { const v4u v = q[i]; const float f = tt < 2 ? fa[i] : fs[i];
            const int a0 = (int)__builtin_rintf(bflo(v.x) * g0.x * f), a1 = (int)__builtin_rintf(bfhi(v.x) * g0.y * f), a2 = (int)__builtin_rintf(bflo(v.y) * g0.z * f), a3 = (int)__builtin_rintf(bfhi(v.y) * g0.w * f);
            const int a4 = (int)__builtin_rintf(bflo(v.z) * g1.x * f), a5 = (int)__builtin_rintf(bfhi(v.z) * g1.y * f), a6 = (int)__builtin_rintf(bflo(v.w) * g1.z * f), a7 = (int)__builtin_rintf(bfhi(v.w) * g1.w * f);
            v2u p; p.x = (unsigned)(a0 & 255) | ((unsigned)(a1 & 255) << 8) | ((unsigned)(a2 & 255) << 16) | ((unsigned)(a3 & 255) << 24);
            p.y = (unsigned)(a4 & 255) | ((unsigned)(a5 & 255) << 8) | ((unsigned)(a6 & 255) << 16) | ((unsigned)(a7 & 255) << 24);
            *(GAS v2u*)(F.MIXQ + (size_t)(q0 + 4 * i + rl) * DM + colt + 8 * c) = p; } }
}
DI void p2_mixers(Frame& F) {
    LAS unsigned char* wl = F.lds + F.wave * 16384;
    LAS float* scr = (LAS float*)(F.lds + RING_BYTES) + F.wave * 128;
    LAS float* xch = (LAS float*)(F.lds + RING_BYTES + 4096);
    LAS float* gqk = (LAS float*)(F.lds + RING_BYTES + 8192);
    if (F.tid < HD) gqk[F.tid] = F.q_g[F.tid] * F.k_g[F.tid] * QSCALE;
    __syncthreads();
    const int lane = F.lane, r = lane & 31, h = lane >> 5, w = F.wave;
    for (int unit = F.vcu; unit < T / 32; unit += F.G) {
        asm volatile("" : "+v"(F.lane));
        const int q0 = 32 * unit, n = unit >> 2, rq = unit & 3;
        float ssa = 0.f, sss = 0.f; float mxa[8], mxs[8];
#pragma unroll
        for (int i = 0; i < 8; ++i) { mxa[i] = 0.f; mxs[i] = 0.f; }
#pragma unroll 1
        for (int hh = 0; hh < 2; ++hh) attn_head(F, 2 * w + hh, q0, scr, gqk, wl, ssa, mxa);
#pragma unroll 1
        for (int hh = 0; hh < 2; ++hh) sgu_group(F, 2 * w + hh, n, rq, scr, wl, sss, mxs);
        if (h == 0) { xch[w * 32 + r] = ssa; xch[256 + w * 32 + r] = sss; }
#pragma unroll
        for (int i = 0; i < 8; ++i) { const float a = row_fmax(mxa[i]), b = row_fmax(mxs[i]); if ((lane & 15) == 0) { xch[512 + w * 32 + 4 * i + (lane >> 4)] = a; xch[768 + w * 32 + 4 * i + (lane >> 4)] = b; } }
        VM_WAIT();
        __syncthreads();
        float ta = 0.f, ts = 0.f, ma = 0.f, ms = 0.f;
#pragma unroll
        for (int ww = 0; ww < 8; ++ww) { ta += xch[ww * 32 + r]; ts += xch[256 + ww * 32 + r]; ma = __builtin_fmaxf(ma, xch[512 + ww * 32 + r]); ms = __builtin_fmaxf(ms, xch[768 + ww * 32 + r]); }
        const float rsa = __builtin_amdgcn_rsqf(ta * (1.f / SBW) + EPS), rss = __builtin_amdgcn_rsqf(ts * (1.f / SBW) + EPS);
        const float rowmax = __builtin_fmaxf(rsa * ma, rss * ms), inv = rowmax > 0.f ? 127.0f / rowmax : 0.f;
        if (h == 0) { scr[r] = rsa * inv; scr[32 + r] = rss * inv; if (w == 0) F.SA2[q0 + r] = rowmax * (1.0f / 127.0f); }
        renorm_q8(F, q0, scr, scr + 32, w, lane);
        __syncthreads();
    }
}

DI unsigned f_ord(float f) { const unsigned u = __float_as_uint(f); return (u & 0x80000000u) ? ~u : (u | 0x80000000u); }
DI float ord_f(unsigned k) { return __uint_as_float((k & 0x80000000u) ? (k ^ 0x80000000u) : ~k); }
DI unsigned bperm(unsigned v, int src_lane) { return (unsigned)__builtin_amdgcn_ds_bpermute(src_lane << 2, (int)v); }

constexpr int P5_D = 8;
constexpr int P5_SLOT = 1024;
constexpr int P5_USL = P5_D * P5_SLOT;
constexpr int P5_PART = P5_USL + 2048;
constexpr int P5_VSL = P5_PART + 2048;
constexpr int P5_WAVE = 19456;
DI void p5_dma_half(const unsigned char* tbase, unsigned roff, LAS unsigned char* slot, int lane) {
    __builtin_amdgcn_global_load_lds((const unsigned*)(tbase + (size_t)(roff + 16u * (unsigned)lane)), (LAS unsigned*)(slot), 16, 0, 0);
}
static_assert(TROW == 2048, "ent_off");
DI unsigned ent_off(unsigned e) { return (e >> 16) << 11; }
DI int tr_reduce16(const int (&p)[16], int lane) {
    const bool b0 = lane & 1, b1 = lane & 2, b2 = lane & 4, b3 = lane & 8;
    int a[8], q[4], c[2];
#pragma unroll
    for (int i = 0; i < 8; ++i) { const int keep = b0 ? p[2 * i + 1] : p[2 * i], send = b0 ? p[2 * i] : p[2 * i + 1]; a[i] = keep + (int)dpp_u<0xB1>((unsigned)send); }
#pragma unroll
    for (int i = 0; i < 4; ++i) { const int keep = b1 ? a[2 * i + 1] : a[2 * i], send = b1 ? a[2 * i] : a[2 * i + 1]; q[i] = keep + (int)dpp_u<0x4E>((unsigned)send); }
#pragma unroll
    for (int i = 0; i < 2; ++i) { const int keep = b2 ? q[2 * i + 1] : q[2 * i], send = b2 ? q[2 * i] : q[2 * i + 1]; c[i] = keep + __builtin_amdgcn_ds_swizzle(send, 0x101F); }
    int d; { const int keep = b3 ? c[1] : c[0], send = b3 ? c[0] : c[1]; d = keep + __builtin_amdgcn_ds_swizzle(send, 0x201F); }
    d += __builtin_amdgcn_ds_swizzle(d, 0x401F);
    const auto rr = __builtin_amdgcn_permlane32_swap((unsigned)d, (unsigned)d, false, false); return (int)(rr[0] + rr[1]);
}
DI void p5_peer(Frame& F, const XcdBarrier& bar) {
    static_assert(P5_D == 8 && P5_VSL + 2048 <= 17408 && P5_WAVE * NWAVES <= LDSCTL_OFF, "P5 LDS map");
    const int lane = F.lane, gw = F.vcu * NWAVES + F.wave, NGW = F.G * NWAVES;
    LAS unsigned char* ring = F.lds + F.wave * P5_WAVE;
    LAS float* part = (LAS float*)(ring + P5_PART);
    LAS float* usl = (LAS float*)(ring + P5_USL); LAS float* vsl = (LAS float*)(ring + P5_VSL);
    LAS unsigned* ent = (LAS unsigned*)(ring + 17408);
    LAS unsigned* hst = (LAS unsigned*)ring;
    LAS int* tids = (LAS int*)(ring + 16384); LAS float* tgc = (LAS float*)(ring + 16384 + 512);
    LAS float* ascl = (LAS float*)(F.lds + LDSCTL_OFF + 2048 + F.wave * 16);
    int pa, pb;
    { const int l = lane;
      if (l < 16) { pa = 0; pb = l; } else if (l < 24) { pa = 1; pb = l - 16; } else if (l < 29) { pa = 2; pb = l - 24; } else if (l < 33) { pa = 3; pb = l - 29; }
      else if (l < 36) { pa = 4; pb = l - 33; } else if (l < 38) { pa = 5; pb = l - 36; } else if (l < 40) { pa = 6; pb = l - 38; } else if (l < 42) { pa = 7; pb = l - 40; }
      else if (l < 50) { pa = l - 34; pb = 0; } else { pa = 0; pb = 0; } }
    const unsigned pab = (unsigned)(pa << 4 | pb);
    for (int g = gw; g < T / 4; g += NGW) {
        const bool first = (g == gw);
        v2u gpk[16]; f32x4 hs4;
        { int lane = F.lane; asm volatile("" : "+v"(lane));
          hs4 = *(const GAS f32x4*)(F.HSS + (size_t)lane * T + 4 * g);
#pragma unroll
          for (int jj = 0; jj < 16; ++jj) { const f32x4 gn = ((const GAS f32x4*)F.ffn_g)[lane + 64 * jj]; gpk[jj].x = pk2(gn.x, gn.y); gpk[jj].y = pk2(gn.z, gn.w); } }
#pragma unroll 1
        for (int tok = 0; tok < 4; ++tok) {
            int lane = F.lane; asm volatile("" : "+v"(lane));
            const int t = 4 * g + tok;
            const float rstd = __builtin_amdgcn_rsqf(wave_fsum_u(tok == 0 ? hs4.x : tok == 1 ? hs4.y : tok == 2 ? hs4.z : hs4.w) * (1.f / DM) + EPS);
            { const GAS v2u* hp = (const GAS v2u*)(F.HB + (size_t)t * DM) + lane; float hv[64]; float m = 0.f;
#pragma unroll
              for (int jj = 0; jj < 16; ++jj) { const v2u q = hp[64 * jj]; const v2u gq = gpk[jj];
                  hv[4 * jj] = bflo(q.x) * bflo(gq.x); hv[4 * jj + 1] = bfhi(q.x) * bfhi(gq.x); hv[4 * jj + 2] = bflo(q.y) * bflo(gq.y); hv[4 * jj + 3] = bfhi(q.y) * bfhi(gq.y);
                  m = __builtin_fmaxf(__builtin_fmaxf(m, __builtin_fmaxf(__builtin_fabsf(hv[4 * jj]), __builtin_fabsf(hv[4 * jj + 1]))), __builtin_fmaxf(__builtin_fabsf(hv[4 * jj + 2]), __builtin_fabsf(hv[4 * jj + 3]))); }
              m = wave_fmax_u(m);
              const float inv = m > 0.f ? 119.0f / m : 0.f; unsigned wh[8], wl[8];
              constexpr float HMAGIC = 12582912.0f + 136.0f; constexpr unsigned HK = 0x4B400000u * 0x01010101u;
#pragma unroll
              for (int j = 0; j < 8; ++j) { unsigned t0 = 0u, t1 = 0u;
#pragma unroll
                  for (int n = 0; n < 4; ++n) { t0 += __float_as_uint(__builtin_fmaf(hv[8 * j + n], inv, HMAGIC)) << (8 * n); t1 += __float_as_uint(__builtin_fmaf(hv[8 * j + 4 + n], inv, HMAGIC)) << (8 * n); }
                  t0 -= HK; t1 -= HK;
                  wl[j] = ((t0 & 0x0F0F0F0Fu) | ((t1 & 0x0F0F0F0Fu) << 4)) ^ 0x88888888u;
                  wh[j] = (((t0 >> 4) & 0x0F0F0F0Fu) | (t1 & 0xF0F0F0F0u)) ^ 0x88888888u; }
              LAS v4u* hw = (LAS v4u*)(hst + (tok * 64 + lane) * 16);
              v4u o; o.x = wh[0]; o.y = wh[1]; o.z = wh[2]; o.w = wh[3]; hw[0] = o; o.x = wh[4]; o.y = wh[5]; o.z = wh[6]; o.w = wh[7]; hw[1] = o;
              o.x = wl[0]; o.y = wl[1]; o.z = wl[2]; o.w = wl[3]; hw[2] = o; o.x = wl[4]; o.y = wl[5]; o.z = wl[6]; o.w = wl[7]; hw[3] = o;
              if (lane == 0) ascl[tok] = rstd * m * (1.0f / 119.0f); }
            const float* scrow = F.SC + (size_t)t * NSC;
            for (int hd = 0; hd < PH; hd += 2) {
                const int qrow_ = gw + (tok * 4 + (hd >> 1)) * NGW; const int qrow = (first && qrow_ < 2 * NEXP) ? qrow_ : gw;
                const int rho = lane >> 4, i16 = lane & 15;
                const float* sp = scrow + (hd + (rho >> 1)) * 256 + (rho & 1) * 128 + 8 * i16;
                const f32x4 sva = *(const GAS f32x4*)sp, svb = *(const GAS f32x4*)(sp + 4);
                asm volatile("" ::: "memory");
                f32x4 qv[16];
                tq_load(F, qrow, lane, qv);
                unsigned sk[8], res = 0u;
                { const unsigned idx0 = (unsigned)(8 * i16); const float sv8[8] = {sva.x, sva.y, sva.z, sva.w, svb.x, svb.y, svb.z, svb.w};
#pragma unroll
                  for (int e = 0; e < 8; ++e) sk[e] = (f_ord(sv8[e]) & ~0x7Fu) | (idx0 + e);
                  constexpr int NET[19][2] = {{0,1},{2,3},{4,5},{6,7},{0,2},{1,3},{4,6},{5,7},{1,2},{5,6},{0,4},{1,5},{2,6},{3,7},{2,4},{3,5},{1,2},{3,4},{5,6}};
#pragma unroll
                  for (int c = 0; c < 19; ++c) { const unsigned hi = umax(sk[NET[c][0]], sk[NET[c][1]]), lo = umin(sk[NET[c][0]], sk[NET[c][1]]); sk[NET[c][0]] = hi; sk[NET[c][1]] = lo; } }
#pragma unroll
                for (int rnd = 0; rnd < PK; ++rnd) {
                    const unsigned mm = row_umax(sk[0]);
                    const bool win = (sk[0] == mm);
#pragma unroll
                    for (int e = 0; e < 7; ++e) sk[e] = win ? sk[e + 1] : sk[e];
                    sk[7] = win ? 0u : sk[7];
                    res = (i16 == rnd) ? mm : res;
                }
                unsigned ck[2], res2[2];
#pragma unroll
                for (int h = 0; h < 2; ++h) { const unsigned ka = bperm(res, 32 * h + pa), kb = bperm(res, 32 * h + 16 + pb);
                    const float cv = ord_f(ka & ~0x7Fu) + ord_f(kb & ~0x7Fu);
                    ck[h] = (lane < 50) ? ((f_ord(cv) & ~0x3Fu) | (unsigned)lane) : 0u; res2[h] = 0u; }
                { unsigned rk[2] = {0u, 0u};
#pragma unroll
                  for (int c = 0; c < 50; ++c) {
#pragma unroll
                      for (int h = 0; h < 2; ++h) { const unsigned sk = (unsigned)__builtin_amdgcn_readlane((int)ck[h], c); rk[h] += (sk > ck[h]) ? 1u : 0u; } }
#pragma unroll
                  for (int h = 0; h < 2; ++h) { const unsigned dst = (lane < 50) ? rk[h] : (unsigned)lane; res2[h] = (unsigned)__builtin_amdgcn_ds_permute((int)(dst << 2), (int)ck[h]); } }
#pragma unroll
                for (int h = 0; h < 2; ++h) {
                    const unsigned pid = res2[h] & 0x3Fu; const unsigned ab = bperm(pab, (int)pid);
                    const unsigned i1 = bperm(res, 32 * h + (int)(ab >> 4)) & 0x7Fu, i2 = bperm(res, 32 * h + 16 + (int)(ab & 15u)) & 0x7Fu;
                    const int expert = (int)(i1 * PNK + i2);
                    const float best = ord_f(res2[h] & ~0x3Fu) * rstd;
                    const float bmax = __uint_as_float((unsigned)__builtin_amdgcn_readlane((int)__float_as_uint(best), 0));
                    const float ex = (lane < 16) ? __builtin_amdgcn_exp2f((best - bmax) * 1.4426950408889634f) : 0.f;
                    const float gate = (lane < 16) ? ex * __builtin_amdgcn_rcpf(row_fsum(ex)) : 0.f;
                    if (lane < 16) { tids[(hd + h) * 16 + lane] = expert; tgc[(hd + h) * 16 + lane] = gate; }
                }
                tq_store(F, qrow, lane, qv);
            }
            { const int e0 = tids[lane], e1 = tids[64 + lane]; const float g0 = tgc[lane], g1 = tgc[64 + lane];
              LAS unsigned* cnt = (LAS unsigned*)tids; LAS unsigned* pre = (LAS unsigned*)tgc;
              cnt[lane] = 0u; cnt[64 + lane] = 0u;
              const int b0 = e0 >> 7, b1 = e1 >> 7;
              const unsigned p0 = __hip_atomic_fetch_add(cnt + b0, 1u, __ATOMIC_RELAXED, __HIP_MEMORY_SCOPE_WORKGROUP), p1 = __hip_atomic_fetch_add(cnt + b1, 1u, __ATOMIC_RELAXED, __HIP_MEMORY_SCOPE_WORKGROUP);
              const unsigned c0 = cnt[lane], c1 = cnt[64 + lane];
              unsigned x0 = c0, x1 = c1;
              x0 += dpp_u<0x111>(x0); x1 += dpp_u<0x111>(x1); x0 += dpp_u<0x112>(x0); x1 += dpp_u<0x112>(x1); x0 += dpp_u<0x114>(x0); x1 += dpp_u<0x114>(x1); x0 += dpp_u<0x118>(x0); x1 += dpp_u<0x118>(x1);
              const unsigned a0 = (unsigned)__builtin_amdgcn_readlane((int)x0, 15), a1 = (unsigned)__builtin_amdgcn_readlane((int)x0, 31), a2 = (unsigned)__builtin_amdgcn_readlane((int)x0, 47), a3 = (unsigned)__builtin_amdgcn_readlane((int)x0, 63);
              const unsigned d0 = (unsigned)__builtin_amdgcn_readlane((int)x1, 15), d1 = (unsigned)__builtin_amdgcn_readlane((int)x1, 31), d2 = (unsigned)__builtin_amdgcn_readlane((int)x1, 47);
              const unsigned tot0 = a0 + a1 + a2 + a3;
              const unsigned o0 = (lane >= 16 ? a0 : 0u) + (lane >= 32 ? a1 : 0u) + (lane >= 48 ? a2 : 0u), o1 = tot0 + (lane >= 16 ? d0 : 0u) + (lane >= 32 ? d1 : 0u) + (lane >= 48 ? d2 : 0u);
              pre[lane] = x0 + o0 - c0; pre[64 + lane] = x1 + o1 - c1;
              const unsigned s0 = pre[b0] + p0, s1 = pre[b1] + p1;
              ent[tok * 128 + s0] = ((unsigned)e0 << 16) | f2bf(g0); ent[tok * 128 + s1] = ((unsigned)e1 << 16) | f2bf(g1); }
        }
        int lane = F.lane; asm volatile("" : "+v"(lane));
        if (first) {
            for (int qrow = gw + 16 * NGW; qrow < 2 * NEXP; qrow += NGW) { f32x4 qv[16]; tq_load(F, qrow, lane, qv); tq_store(F, qrow, lane, qv); }
            xcd_barrier(bar);
        }
        asm volatile("s_waitcnt vmcnt(0) lgkmcnt(0)" ::: "memory");
        int Hh[4][8], Hl[4][8]; float asc[4];
#pragma unroll
        for (int tok = 0; tok < 4; ++tok) { const LAS v4u* p = (const LAS v4u*)(hst + (tok * 64 + lane) * 16); const v4u a = p[0], b = p[1], c = p[2], d = p[3];
            Hh[tok][0] = (int)a.x; Hh[tok][1] = (int)a.y; Hh[tok][2] = (int)a.z; Hh[tok][3] = (int)a.w; Hh[tok][4] = (int)b.x; Hh[tok][5] = (int)b.y; Hh[tok][6] = (int)b.z; Hh[tok][7] = (int)b.w;
            Hl[tok][0] = (int)c.x; Hl[tok][1] = (int)c.y; Hl[tok][2] = (int)c.z; Hl[tok][3] = (int)c.w; Hl[tok][4] = (int)d.x; Hl[tok][5] = (int)d.y; Hl[tok][6] = (int)d.z; Hl[tok][7] = (int)d.w;
            asc[tok] = ascl[tok]; }
        const unsigned vfirst = ent_off(ent[((lane >> 2) & 1) * 128 + (lane & 3)]);
        const unsigned fe = ent_off(ent[(lane & 3) * 128 + ((lane >> 2) & 1)]);
        asm volatile("s_waitcnt lgkmcnt(0)" ::: "memory");
#pragma unroll
        for (int tok = 0; tok < 4; ++tok) { const unsigned e0 = ent[tok * 128 + lane] >> 16, e1 = ent[tok * 128 + 64 + lane] >> 16;
            usl[tok * 128 + lane] = F.USC[e0]; usl[tok * 128 + 64 + lane] = F.USC[e1]; vsl[tok * 128 + lane] = F.VSC[e0]; vsl[tok * 128 + 64 + lane] = F.VSC[e1]; }
        asm volatile("s_waitcnt vmcnt(0)" ::: "memory");
#pragma unroll
        for (int r = 0; r < P5_D; ++r) p5_dma_half(F.UT, (unsigned)__builtin_amdgcn_readlane((int)fe, r), ring + r * P5_SLOT, lane);
        v4u cu[4];
        asm volatile("s_waitcnt vmcnt(4)" ::: "memory");
#pragma unroll
        for (int tok = 0; tok < 4; ++tok) cu[tok] = ((const LAS v4u*)(ring + tok * P5_SLOT))[lane];
#pragma unroll
        for (int uh = 0; uh < 2; ++uh) {
            for (int b = 0; b < 8; ++b) {
                int lane = F.lane; asm volatile("" : "+v"(lane));
                unsigned nentv[4];
#pragma unroll
                for (int tok = 0; tok < 4; ++tok) { const int n = 16 * b + 2 + (lane & 15); nentv[tok] = ent_off(ent[tok * 128 + (n < 128 ? n : 127)]); }
                int P[4][16];
#pragma unroll
                for (int kk = 0; kk < 16; kk += 2) {
#pragma unroll
                    for (int k2 = 0; k2 < 2; ++k2) {
                        const int k = kk + k2;
                        const bool wrap = (b == 7 && kk == 14);
                        asm volatile("s_waitcnt lgkmcnt(0)" ::: "memory");
#pragma unroll
                        for (int tok = 0; tok < 4; ++tok) asm volatile("" : "+v"(cu[tok].x), "+v"(cu[tok].y), "+v"(cu[tok].z), "+v"(cu[tok].w));
#pragma unroll
                        for (int tok = 0; tok < 4; ++tok) {
                            unsigned ne = (unsigned)__builtin_amdgcn_readlane((int)nentv[tok], k); const unsigned char* base = F.UT; int hoff = 1024 * uh;
                            if (wrap) {
                                if (uh == 0) { ne = (unsigned)__builtin_amdgcn_readlane((int)fe, 4 * k2 + tok); hoff = 1024; }
                                else { ne = (unsigned)__builtin_amdgcn_readlane((int)vfirst, 4 * k2 + tok); base = F.VT; hoff = 0; } }
                            p5_dma_half(base + hoff, ne, ring + (4 * k2 + tok) * P5_SLOT, lane); }
                        asm volatile("s_waitcnt vmcnt(4)" ::: "memory");
                        v4u nx4[4];
#pragma unroll
                        for (int tok = 0; tok < 4; ++tok) nx4[tok] = ((const LAS v4u*)(ring + (4 * (k2 ^ 1) + tok) * P5_SLOT))[lane];
                        unsigned uw[4][4];
#pragma unroll
                        for (int tok = 0; tok < 4; ++tok) { uw[tok][0] = cu[tok].x; uw[tok][1] = cu[tok].y; uw[tok][2] = cu[tok].z; uw[tok][3] = cu[tok].w;
                            asm volatile("" : "+v"(uw[tok][0]), "+v"(uw[tok][1]), "+v"(uw[tok][2]), "+v"(uw[tok][3])); }
                        int is0[4], is1[4];
#pragma unroll
                        for (int tok = 0; tok < 4; ++tok) {
                            asm("v_dot8_i32_i4 %0, %1, %2, 0" : "=v"(is0[tok]) : "v"(Hh[tok][4 * uh]), "v"(uw[tok][0]));
                            asm("v_dot8_i32_i4 %0, %1, %2, 0" : "=v"(is1[tok]) : "v"(Hl[tok][4 * uh]), "v"(uw[tok][0])); }
#pragma unroll
                        for (int jj = 1; jj < 4; ++jj) {
#pragma unroll
                            for (int tok = 0; tok < 4; ++tok) { is0[tok] = __builtin_amdgcn_sdot8(Hh[tok][4 * uh + jj], (int)uw[tok][jj], is0[tok], false); is1[tok] = __builtin_amdgcn_sdot8(Hl[tok][4 * uh + jj], (int)uw[tok][jj], is1[tok], false); } }
#pragma unroll
                        for (int tok = 0; tok < 4; ++tok) { int pv = 16 * is0[tok] + is1[tok];
                            asm volatile("" : "+v"(pv));
                            P[tok][k] = pv; cu[tok] = nx4[tok]; }
                    }
                }
#pragma unroll
                for (int tok = 0; tok < 4; ++tok) { const int tot = tr_reduce16(P[tok], lane);
                    if (lane < 16) { const int ei = tok * 128 + 16 * b + lane; LAS int* parti = (LAS int*)part;
                        if (uh == 0) parti[ei] = tot;
                        else { const unsigned e = ent[ei]; ent[ei] = (e & 0xffff0000u) | f2bf(__uint_as_float(e << 16) * pg8::gelu_tanh((float)(parti[ei] + tot) * usl[ei] * asc[tok])); } } }
            }
        }
        float Q[4]; int csum[4]; LAS unsigned* cql = (LAS unsigned*)usl;
#pragma unroll
        for (int tok = 0; tok < 4; ++tok) { const int i0 = tok * 128 + lane, i1 = i0 + 64; const unsigned e0 = ent[i0], e1 = ent[i1];
            const float c0 = __uint_as_float(f2bf(__uint_as_float(e0 << 16) * vsl[i0]) << 16), c1 = __uint_as_float(f2bf(__uint_as_float(e1 << 16) * vsl[i1]) << 16);
            const float gm = wave_fmax_u(__builtin_fmaxf(__builtin_fabsf(c0), __builtin_fabsf(c1)));
            const float qinv = gm > 0.f ? 127.0f / gm : 0.f; Q[tok] = gm * (1.0f / 127.0f);
            const int k0 = (int)__builtin_rintf(c0 * qinv), k1 = (int)__builtin_rintf(c1 * qinv);
            { int t = k0 + k1; t += (int)dpp_u<0xB1>((unsigned)t); t += (int)dpp_u<0x4E>((unsigned)t); t += (int)dpp_u<0x124>((unsigned)t); t += (int)dpp_u<0x128>((unsigned)t);
              csum[tok] = (__builtin_amdgcn_readlane(t, 0) + __builtin_amdgcn_readlane(t, 16)) + (__builtin_amdgcn_readlane(t, 32) + __builtin_amdgcn_readlane(t, 48)); }
            const unsigned b0 = (unsigned)k0 & 255u, b1 = (unsigned)k1 & 255u;
            const unsigned w0 = dpp_u<0x00>(b0) | (dpp_u<0x55>(b0) << 8) | (dpp_u<0xAA>(b0) << 16) | (dpp_u<0xFF>(b0) << 24);
            const unsigned w1 = dpp_u<0x00>(b1) | (dpp_u<0x55>(b1) << 8) | (dpp_u<0xAA>(b1) << 16) | (dpp_u<0xFF>(b1) << 24);
            asm volatile("s_waitcnt lgkmcnt(0)" ::: "memory");
            if ((lane & 3) == 0) { cql[tok * 32 + (lane >> 2)] = w0; cql[tok * 32 + 16 + (lane >> 2)] = w1; } }
#pragma unroll 1
        for (int vh = 0; vh < 2; ++vh) {
            int accF[4][16], accL[4][16];
#pragma unroll
            for (int i = 0; i < 16; ++i) {
#pragma unroll
                for (int tok = 0; tok < 4; ++tok) { accF[tok][i] = 0; accL[tok][i] = 0; } }
            for (int blk = 0; blk < 8; ++blk) {
                int lane = F.lane; asm volatile("" : "+v"(lane));
                unsigned curv[4], nx[2];
#pragma unroll
                for (int tok = 0; tok < 4; ++tok) curv[tok] = ent_off(ent[tok * 128 + 16 * blk + (lane & 15)]);
#pragma unroll
                for (int tt = 0; tt < 2; ++tt) nx[tt] = ent_off(ent[tt * 128 + (blk < 7 ? 16 * (blk + 1) + (lane & 3) : (vh == 0 ? (lane & 3) : 127))]);
#pragma unroll
                for (int q4 = 0; q4 < 4; ++q4) {
#pragma unroll
                    for (int tok = 0; tok < 4; ++tok) {
                        constexpr int dummy = 0; (void)dummy;
                        const int sg = 4 * (tok & 1);
                        asm volatile("s_waitcnt vmcnt(4)" ::: "memory");
                        unsigned rw[4][4]; const unsigned cq = cql[tok * 32 + 4 * blk + q4];
#pragma unroll
                        for (int i = 0; i < 4; ++i) { const LAS unsigned char* sl = ring + (sg + i) * P5_SLOT;
                            const v4u a0 = ((const LAS v4u*)sl)[lane];
                            rw[i][0] = a0.x; rw[i][1] = a0.y; rw[i][2] = a0.z; rw[i][3] = a0.w; }
                        asm volatile("s_waitcnt lgkmcnt(0)" ::: "memory");
                        { const int tt = (tok + 2) & 3; int hoff = 1024 * vh; if (tok >= 2 && q4 == 3 && blk == 7 && vh == 0) hoff = 1024;
#pragma unroll
                          for (int i = 0; i < 4; ++i) {
                              const unsigned ne = (tok < 2) ? (unsigned)__builtin_amdgcn_readlane((int)curv[tt], 4 * q4 + i)
                                                : (q4 < 3) ? (unsigned)__builtin_amdgcn_readlane((int)curv[tt], 4 * (q4 + 1) + i) : (unsigned)__builtin_amdgcn_readlane((int)nx[tt], i);
                              p5_dma_half(F.VT + hoff, ne, ring + (sg + i) * P5_SLOT, lane); } }
#pragma unroll
                        for (int j = 0; j < 4; ++j) {
                            const unsigned t01l = __builtin_amdgcn_perm(rw[1][j], rw[0][j], 0x05010400u), t01h = __builtin_amdgcn_perm(rw[1][j], rw[0][j], 0x07030602u);
                            const unsigned t23l = __builtin_amdgcn_perm(rw[3][j], rw[2][j], 0x05010400u), t23h = __builtin_amdgcn_perm(rw[3][j], rw[2][j], 0x07030602u);
                            const unsigned x0 = __builtin_amdgcn_perm(t23l, t01l, 0x05040100u), x1 = __builtin_amdgcn_perm(t23l, t01l, 0x07060302u);
                            const unsigned x2 = __builtin_amdgcn_perm(t23h, t01h, 0x05040100u), x3 = __builtin_amdgcn_perm(t23h, t01h, 0x07060302u);
                            accF[tok][4 * j + 0] = __builtin_amdgcn_sdot4((int)x0, (int)cq, accF[tok][4 * j + 0], false); accL[tok][4 * j + 0] = __builtin_amdgcn_sdot4((int)(x0 & 0x0F0F0F0Fu), (int)cq, accL[tok][4 * j + 0], false);
                            accF[tok][4 * j + 1] = __builtin_amdgcn_sdot4((int)x1, (int)cq, accF[tok][4 * j + 1], false); accL[tok][4 * j + 1] = __builtin_amdgcn_sdot4((int)(x1 & 0x0F0F0F0Fu), (int)cq, accL[tok][4 * j + 1], false);
                            accF[tok][4 * j + 2] = __builtin_amdgcn_sdot4((int)x2, (int)cq, accF[tok][4 * j + 2], false); accL[tok][4 * j + 2] = __builtin_amdgcn_sdot4((int)(x2 & 0x0F0F0F0Fu), (int)cq, accL[tok][4 * j + 2], false);
                            accF[tok][4 * j + 3] = __builtin_amdgcn_sdot4((int)x3, (int)cq, accF[tok][4 * j + 3], false); accL[tok][4 * j + 3] = __builtin_amdgcn_sdot4((int)(x3 & 0x0F0F0F0Fu), (int)cq, accL[tok][4 * j + 3], false);
                        }
                    }
                }
            }
#pragma unroll
            for (int tok = 0; tok < 4; ++tok) { const int t = 4 * g + tok; int lane = F.lane; asm volatile("" : "+v"(lane));
                const GAS v2u* hp = (const GAS v2u*)(F.HB + (size_t)t * DM) + lane + 512 * vh; GAS f32x4* op = (GAS f32x4*)(F.out + (size_t)t * DM) + lane + 512 * vh;
                const int corr = 8 * csum[tok]; const float Qe = Q[tok], Q16 = Q[tok] * 0.0625f;
#pragma unroll
                for (int jj = 0; jj < 8; ++jj) { const v2u q = __builtin_nontemporal_load(hp + 64 * jj); f32x4 a; const int b0 = 2 * jj, b1 = 2 * jj + 1;
                    a.x = bflo(q.x) + Qe * (float)(accL[tok][b0] - corr); a.y = bfhi(q.x) + Q16 * (float)(accF[tok][b0] - accL[tok][b0]);
                    a.z = bflo(q.y) + Qe * (float)(accL[tok][b1] - corr); a.w = bfhi(q.y) + Q16 * (float)(accF[tok][b1] - accL[tok][b1]);
                    __builtin_nontemporal_store(a, op + 64 * jj); } }
        }
        asm volatile("s_waitcnt vmcnt(0)" ::: "memory");
    }
}

struct Args { const float* in[16]; float* out; unsigned char* ws; int ph_lo, ph_hi, li, pad; };
__global__ void __launch_bounds__(NWAVES * 64, 2) mk_fwd(Args args) {
    extern __shared__ __attribute__((aligned(16))) unsigned char lds[];
    Frame F;
    F.lds = (LAS unsigned char*)lds;
    F.MISC = (volatile LAS unsigned*)(F.lds + MISC_OFF);
    F.tid = threadIdx.x; F.lane = F.tid & 63; F.wave = __builtin_amdgcn_readfirstlane(F.tid >> 6);
    F.G = gridDim.x; { const int bx = blockIdx.x; F.vcu = (F.G % 8 == 0) ? (bx % 8) * (F.G / 8) + bx / 8 : bx; }
    unsigned char* ws = args.ws;
    F.ctl = (gu32*)(ws + WS_CTL);
    F.x = args.in[0]; F.mix_g = args.in[1]; F.w_in = args.in[2]; F.q_g = args.in[3]; F.k_g = args.in[4]; F.sgu_vg = args.in[5]; F.sgu_w = args.in[6]; F.sgu_b = args.in[7];
    F.sb_og = args.in[8]; F.sgu_og = args.in[9]; F.w_out = args.in[10]; F.ffn_g = args.in[11]; F.w_q = args.in[12]; F.keys = args.in[13]; F.pu = args.in[14]; F.pv = args.in[15];
    F.out = args.out;
    F.XN = ws + WS_XN; F.WA = ws + WS_WA; F.WB = ws + WS_WB; F.MIXQ = ws + WS_MIXQ; F.WO = ws + WS_WO; F.WS = (bf16*)(ws + WS_WS);
    F.SA = (float*)(ws + WS_SCL); F.SWA = (float*)(ws + WS_SCL + 65536); F.SWB = (float*)(ws + WS_SCL + 131072); F.SA2 = (float*)(ws + WS_SCL + 196608); F.SWO = (float*)(ws + WS_SCL + 262144);
    F.QKU = (bf16*)(ws + WS_QKU); F.VG = (bf16*)(ws + WS_VG); F.MIX = (bf16*)(ws + WS_MIX); F.HB = (bf16*)(ws + WS_HB); F.UT = ws + WS_UT; F.VT = ws + WS_VT;
    F.GVP = (float*)(ws + WS_GVP); F.HSS = (float*)(ws + WS_HSS); F.SC = (float*)(ws + WS_SC); F.USC = (float*)(ws + WS_SCL + 327680); F.VSC = (float*)(ws + WS_SCL + 393216);
    for (int u = F.tid; u < (LDS_BYTES - LDSCTL_OFF) / 4; u += NWAVES * 64) ((LAS unsigned*)(F.lds + LDSCTL_OFF))[u] = 0u;
    __syncthreads();
    XcdBarrier bar; bar.bar = (unsigned*)(F.ctl + CW_BAR); bar.x = 0; bar.st = nullptr;
    if (N_LAUNCHES != PER_PHASE) bar = xcd_barrier_post((unsigned*)(F.ctl + CW_BAR), F.MISC + 8);
#define GRID_BAR() do { if (N_LAUNCHES != PER_PHASE) xcd_barrier(bar); } while (0)
    const int lo = args.ph_lo, hi = args.ph_hi;
#define IN(k) (lo <= (k) && (k) < hi)
#define BOTH(k) (IN(k) && IN((k) + 1))

    if (IN(0)) { p0_prologue(F); if (BOTH(0)) GRID_BAR(); }

    if (IN(1)) {
        { pg8::Gemm g{(const pg8::bf16_t*)F.XN, (const pg8::bf16_t*)F.WA, T, NA, DM / 2}; pg8::StaticOrder S; S.init(T, NA, F.G, (int)blockIdx.x);
          pg8::EpiQKU8 E{F.QKU, F.SA, F.SWA};
          pg8::gemm_phase<pg8::EpiQKU8, pg8::StaticOrder, true, true, true>(F.lds + RING_OFF, g, S, E); }
        { pg8::Gemm g{(const pg8::bf16_t*)F.WB, (const pg8::bf16_t*)F.XN, MB, T, DM / 2}; pg8::StaticOrder S; S.init(MB, T, F.G, (int)blockIdx.x);
          pg8::EpiVT8 E{F.VG, F.GVP, F.SWB, F.SA};
          pg8::gemm_phase<pg8::EpiVT8, pg8::StaticOrder, true, true, true>(F.lds + RING_OFF, g, S, E); }
        if (BOTH(1)) GRID_BAR();
    }

    if (IN(2)) { p2_mixers(F); if (BOTH(2)) GRID_BAR(); }

    if (IN(3)) {
        pg8::Gemm g{(const pg8::bf16_t*)F.MIXQ, (const pg8::bf16_t*)F.WO, T, DM, DM / 2}; pg8::StaticOrder S; S.init(T, DM, F.G, (int)blockIdx.x);
        pg8::EpiH8 E{F.x, F.HB, F.HSS, F.SA2, F.SWO};
        pg8::gemm_phase<pg8::EpiH8, pg8::StaticOrder, true, true, true>(F.lds + RING_OFF, g, S, E);
        if (BOTH(3)) GRID_BAR();
    }

    if (IN(4)) {
        pg8::Gemm g{F.HB, F.WS, T, NSC, DM}; pg8::StaticOrder S; S.init(T, NSC, F.G, (int)blockIdx.x);
        pg8::EpiF32 E{F.SC, NSC};
        pg8::gemm_phase<pg8::EpiF32, pg8::StaticOrder, false, true>(F.lds + RING_OFF, g, S, E);
        if (BOTH(4)) GRID_BAR();
    }

    if (IN(5)) { p5_peer(F, bar); }
#undef IN
#undef BOTH
}

extern "C" void kernel_launch(void* const* d_in, const int* in_sizes, int n_in, void* d_out, int out_size, void* d_ws, size_t ws_size, hipStream_t stream) {
    static int grid = 0;
    if (grid == 0) {
        if (n_in != 16 || in_sizes[0] != T * DM || out_size != T * DM || ws_size < WS_END) { fprintf(stderr, "kernel_launch: unexpected shapes (n_in %d, in0 %d, out %d, ws %zu); nothing launched\n", n_in, n_in > 0 ? in_sizes[0] : -1, out_size, ws_size); grid = -1; return; }
        int dev = 0, cus = 0, per_cu = 0;
        if (hipGetDevice(&dev) != hipSuccess || hipDeviceGetAttribute(&cus, hipDeviceAttributeMultiprocessorCount, dev) != hipSuccess) { grid = -1; return; }
        if (hipFuncSetAttribute((const void*)mk_fwd, hipFuncAttributeMaxDynamicSharedMemorySize, LDS_BYTES) != hipSuccess) { fprintf(stderr, "kernel_launch: hipFuncSetAttribute failed\n"); grid = -1; return; }
        if (hipOccupancyMaxActiveBlocksPerMultiprocessor(&per_cu, (const void*)mk_fwd, NWAVES * 64, LDS_BYTES) != hipSuccess || per_cu < 1) fprintf(stderr, "kernel_launch: occupancy query reports %d per CU\n", per_cu);
        (void)hipGetLastError();
        grid = cus < T / (4 * NWAVES) ? cus : T / (4 * NWAVES);
    }
    if (grid < 0) return;
    if (hipMemsetAsync((char*)d_ws + WS_CTL, 0, CTL_ZERO_BYTES, stream) != hipSuccess) return;
    Args a{};
    for (int i = 0; i < 16; ++i) a.in[i] = (const float*)d_in[i];
    a.out = (float*)d_out; a.ws = (unsigned char*)d_ws;
    if (N_LAUNCHES == 1) {
        a.ph_lo = 0; a.ph_hi = PER_PHASE; a.li = 0;
        void* kargs[] = {&a};
        hipError_t e = hipLaunchCooperativeKernel((const void*)mk_fwd, dim3(grid), dim3(NWAVES * 64), kargs, LDS_BYTES, stream);
        if (e != hipSuccess) fprintf(stderr, "kernel_launch: cooperative launch failed: %s (grid %d)\n", hipGetErrorString(e), grid);
    } else {
        for (int li = 0; li < PER_PHASE; ++li) {
            a.ph_lo = li; a.ph_hi = li + 1; a.li = li;
            hipLaunchKernelGGL(mk_fwd, dim3(grid), dim3(NWAVES * 64), LDS_BYTES, stream, a);
        }
    }
}
```
